# Optimizing an MI355X kernel written in HIP

```python
import math
import jax, jax.numpy as jnp
from jax import lax
import numpy as np

D_MODEL = 1024
BATCH = 4
SEQ = 4096
DEPTH = 1

CHUNK = 64
Q_BLOCK = 128

MLA_HEADS = 8
QK_NOPE_DIM = 64
QK_ROPE_DIM = 32
QK_HEAD_DIM = QK_NOPE_DIM + QK_ROPE_DIM
V_HEAD_DIM = 64
MLA_WIDTH = MLA_HEADS * V_HEAD_DIM
Q_LORA_RANK = 256
KV_LORA_RANK = 128
ROPE_THETA = 10000.0

RNN_WIDTH = 512
RNN_BLOCKS = 8
RNN_BLOCK_DIM = RNN_WIDTH // RNN_BLOCKS
CONV_WIDTH = 4
LRU_C = 8.0

MIX_WIDTH = MLA_WIDTH + RNN_WIDTH

IN_SPLITS = (Q_LORA_RANK, KV_LORA_RANK, QK_ROPE_DIM, MLA_WIDTH, RNN_WIDTH, RNN_WIDTH)
IN_WIDTH = sum(IN_SPLITS)

NORM_EPS = 1e-6

kernel_name = "hymba_mla_rglru_chunk_causal"


def rmsnorm(x, g):
    xf = x.astype(jnp.float32)
    y = xf * lax.rsqrt(jnp.mean(xf * xf, axis=-1, keepdims=True) + NORM_EPS)
    return (y * g.astype(jnp.float32)).astype(x.dtype)


def rope_tables(seq):
    pos = jnp.arange(seq, dtype=jnp.float32)
    inv_freq = ROPE_THETA ** (-jnp.arange(0, QK_ROPE_DIM, 2, dtype=jnp.float32) / QK_ROPE_DIM)
    ang = pos[:, None] * inv_freq[None, :]
    return jnp.cos(ang), jnp.sin(ang)


def apply_rope(x, cos, sin):
    xf = x.astype(jnp.float32)
    x1, x2 = jnp.split(xf, 2, axis=-1)
    out = jnp.concatenate([x1 * cos - x2 * sin, x2 * cos + x1 * sin], axis=-1)
    return out.astype(x.dtype)


def chunk_causal_attention(q, k, v):
    b, s, h, dqk = q.shape
    nqb = s // Q_BLOCK
    scale = 1.0 / math.sqrt(QK_HEAD_DIM)
    qb = q.reshape(b, nqb, Q_BLOCK, h, dqk).transpose(1, 0, 2, 3, 4)
    kf = k.astype(jnp.float32)
    key_chunk = jnp.arange(s) // CHUNK

    def one_block(args):
        q_blk, bi = args
        q_pos = bi * Q_BLOCK + jnp.arange(Q_BLOCK)
        sc = jnp.einsum('bqhd,bkhd->bhqk', q_blk.astype(jnp.float32), kf) * scale
        mask = key_chunk[None, :] <= (q_pos // CHUNK)[:, None]
        sc = jnp.where(mask[None, None], sc, jnp.finfo(jnp.float32).min)
        p = jax.nn.softmax(sc, axis=-1)
        return jnp.einsum('bhqk,bkhd->bqhd', p.astype(v.dtype), v)

    out = lax.map(one_block, (qb, jnp.arange(nqb)))
    return out.transpose(1, 0, 2, 3, 4).reshape(b, s, h * v.shape[-1])


def causal_depthwise_conv(x, w, bias):
    c = x.shape[-1]
    y = lax.conv_general_dilated(
        x, w[:, None, :].astype(x.dtype), window_strides=(1,),
        padding=((CONV_WIDTH - 1, 0),), dimension_numbers=('NWC', 'WIO', 'NWC'),
        feature_group_count=c)
    return y + bias.astype(x.dtype)


def rg_lru(x, w_a, b_a, w_x, b_x, lru_param):
    b, s, _ = x.shape
    xf = x.astype(jnp.float32)
    xb = xf.reshape(b, s, RNN_BLOCKS, RNN_BLOCK_DIM)
    r = jax.nn.sigmoid(jnp.einsum('bsnc,ncd->bsnd', xb, w_a.astype(jnp.float32)).reshape(b, s, -1)
                       + b_a.astype(jnp.float32))
    i = jax.nn.sigmoid(jnp.einsum('bsnc,ncd->bsnd', xb, w_x.astype(jnp.float32)).reshape(b, s, -1)
                       + b_x.astype(jnp.float32))
    log_a = -LRU_C * r * jax.nn.softplus(-lru_param.astype(jnp.float32))
    a = jnp.exp(log_a)
    mult = jnp.sqrt(jnp.clip(1.0 - jnp.exp(2.0 * log_a), 1e-12, None))
    is_start = (jnp.arange(s) == 0)[None, :, None]
    mult = jnp.where(is_start, 1.0, mult)
    u = mult * (i * xf)

    def combine(left, right):
        a_l, h_l = left
        a_r, h_r = right
        return a_l * a_r, a_r * h_l + h_r

    _, h = lax.associative_scan(combine, (a, u), axis=1)
    return h.astype(x.dtype)


def setup_inputs(seed: int = 0) -> dict:
    key = jax.random.key(seed)
    ks = jax.random.split(key, 20)
    f32 = jnp.float32

    def w(k, shape, fan_in):
        return jax.random.normal(k, shape, f32) * (fan_in ** -0.5)

    def gain(k, shape):
        return 1.0 + 0.05 * jax.random.normal(k, shape, f32)

    def bias(k, shape):
        return 0.01 * jax.random.normal(k, shape, f32)

    u = jax.random.uniform(ks[13], (DEPTH, RNN_WIDTH), f32, 0.9, 0.999)
    base = u ** (1.0 / LRU_C)
    lru_param = jnp.log(base) - jnp.log1p(-base)

    return {
        "x": jax.random.normal(ks[0], (BATCH, SEQ, D_MODEL), f32),
        "norm_in_g": gain(ks[1], (DEPTH, D_MODEL)),
        "w_in": w(ks[2], (DEPTH, D_MODEL, IN_WIDTH), D_MODEL),
        "q_norm_g": gain(ks[3], (DEPTH, Q_LORA_RANK)),
        "w_q_b": w(ks[4], (DEPTH, Q_LORA_RANK, MLA_HEADS * QK_HEAD_DIM), Q_LORA_RANK),
        "kv_norm_g": gain(ks[5], (DEPTH, KV_LORA_RANK)),
        "w_kv_b": w(ks[6], (DEPTH, KV_LORA_RANK, MLA_HEADS * (QK_NOPE_DIM + V_HEAD_DIM)), KV_LORA_RANK),
        "conv_w": w(ks[7], (DEPTH, CONV_WIDTH, RNN_WIDTH), CONV_WIDTH),
        "conv_b": bias(ks[8], (DEPTH, RNN_WIDTH)),
        "w_rg_a": w(ks[9], (DEPTH, RNN_BLOCKS, RNN_BLOCK_DIM, RNN_BLOCK_DIM), RNN_BLOCK_DIM),
        "b_rg_a": bias(ks[10], (DEPTH, RNN_WIDTH)),
        "w_rg_x": w(ks[11], (DEPTH, RNN_BLOCKS, RNN_BLOCK_DIM, RNN_BLOCK_DIM), RNN_BLOCK_DIM),
        "b_rg_x": bias(ks[12], (DEPTH, RNN_WIDTH)),
        "lru_param": lru_param,
        "out_norm_mla_g": gain(ks[14], (DEPTH, MLA_WIDTH)),
        "out_norm_rnn_g": gain(ks[15], (DEPTH, RNN_WIDTH)),
        "w_out": w(ks[16], (DEPTH, MIX_WIDTH, D_MODEL), MIX_WIDTH),
        "final_norm_g": gain(ks[17], (D_MODEL,)),
    }


def reference(x, norm_in_g, w_in, q_norm_g, w_q_b, kv_norm_g, w_kv_b, conv_w, conv_b,
              w_rg_a, b_rg_a, w_rg_x, b_rg_x, lru_param, out_norm_mla_g, out_norm_rnn_g,
              w_out, final_norm_g):
    b, s, _ = x.shape
    cos, sin = rope_tables(s)
    offs = np.cumsum(IN_SPLITS)[:-1].tolist()

    for l in range(DEPTH):
        h = rmsnorm(x, norm_in_g[l])
        z = jnp.einsum('bsd,de->bse', h, w_in[l])
        q_lat, kv_lat, k_rope, g_mla, x_rnn, g_rnn = jnp.split(z, offs, axis=-1)

        q = jnp.einsum('bsr,re->bse', rmsnorm(q_lat, q_norm_g[l]), w_q_b[l])
        q = q.reshape(b, s, MLA_HEADS, QK_HEAD_DIM)
        q_nope, q_pe = q[..., :QK_NOPE_DIM], q[..., QK_NOPE_DIM:]
        q_pe = apply_rope(q_pe, cos[:, None, :], sin[:, None, :])
        kv = jnp.einsum('bsr,re->bse', rmsnorm(kv_lat, kv_norm_g[l]), w_kv_b[l])
        kv = kv.reshape(b, s, MLA_HEADS, QK_NOPE_DIM + V_HEAD_DIM)
        k_nope, v = kv[..., :QK_NOPE_DIM], kv[..., QK_NOPE_DIM:]
        k_pe = apply_rope(k_rope, cos, sin)
        k_pe = jnp.broadcast_to(k_pe[:, :, None, :], (b, s, MLA_HEADS, QK_ROPE_DIM))
        q_full = jnp.concatenate([q_nope, q_pe], axis=-1)
        k_full = jnp.concatenate([k_nope, k_pe], axis=-1)
        y_mla = chunk_causal_attention(q_full, k_full, v)

        xr = causal_depthwise_conv(x_rnn, conv_w[l], conv_b[l])
        y_rnn = rg_lru(xr, w_rg_a[l], b_rg_a[l], w_rg_x[l], b_rg_x[l], lru_param[l])

        y_mla = rmsnorm(y_mla, out_norm_mla_g[l]) * jax.nn.silu(g_mla)
        y_rnn = rmsnorm(y_rnn, out_norm_rnn_g[l]) * jax.nn.silu(g_rnn)
        y = jnp.concatenate([y_mla, y_rnn], axis=-1)
        x = x + jnp.einsum('bse,ed->bsd', y, w_out[l])

    return rmsnorm(x, final_norm_g)
```

```cpp
#include <hip/hip_runtime.h>
#include <cstdio>
#include <cstdint>

#ifndef MK_LAUNCHES
#define MK_LAUNCHES 1
#endif

#define LAS __attribute__((address_space(3)))
typedef unsigned short bf16_t;
typedef unsigned u32x4 __attribute__((ext_vector_type(4)));
typedef unsigned u32x2 __attribute__((ext_vector_type(2)));
typedef float f32x4 __attribute__((ext_vector_type(4)));

constexpr int NB = 4, S = 4096, T = NB * S, DM = 1024;
constexpr int NZ = 2048, INW = 1952;
constexpr int OQ = 0, OKV = 256, OKR = 384, OGM = 416, OXR = 928, OGR = 1440;
constexpr int NH = 8, DQK = 96, DNOPE = 64, DROPE = 32, DV = 64;
constexpr int QW = NH * DQK;
constexpr int RW = 512, CH = 64, NCH = S / CH;
constexpr float EPS = 1e-6f;
constexpr float QSCALE = 0.10206207261596575f * 1.4426950408889634f;
constexpr int NPHASE = 7;

constexpr size_t MiB = 1u << 20;
constexpr size_t WS_BAR = 0;
constexpr size_t WS_WIN = 1 * MiB;
constexpr size_t WS_WQ = 5 * MiB;
constexpr size_t WS_WKV = 5 * MiB + 512 * 1024;
constexpr size_t WS_WOUT = 6 * MiB;
constexpr size_t WS_WGA = 8 * MiB;
constexpr size_t WS_WGX = 8 * MiB + 64 * 1024;
constexpr size_t WS_ROPE = 8 * MiB + 256 * 1024;
constexpr size_t WS_RSX = 9 * MiB;
constexpr size_t WS_SP = 9 * MiB + 128 * 1024;
constexpr size_t WS_XB = 16 * MiB;
constexpr size_t WS_Y = 16 * MiB;
constexpr size_t WS_Z = 48 * MiB;
constexpr size_t WS_Q = 112 * MiB;
constexpr size_t WS_K = 136 * MiB;
constexpr size_t WS_VT = 160 * MiB;
constexpr size_t WS_YM = 176 * MiB;
constexpr size_t WS_HL = 192 * MiB;
constexpr size_t WS_CA = 208 * MiB;
constexpr size_t WS_AE = 224 * MiB;
constexpr size_t WS_HE = 225 * MiB;
constexpr size_t WS_CARRY = 226 * MiB;
constexpr size_t WS_END = 227 * MiB;

constexpr int LDS_MAIN = 68 * 1024;
constexpr int LDS_MISC = LDS_MAIN;
constexpr int LDS_BYTES = LDS_MAIN + 64;

__device__ __forceinline__ float bf2f(unsigned u16) { return __uint_as_float(u16 << 16); }
__device__ __forceinline__ float bflo(unsigned w) { return __uint_as_float(w << 16); }
__device__ __forceinline__ float bfhi(unsigned w) { return __uint_as_float(w & 0xffff0000u); }
__device__ __forceinline__ unsigned f2bf(float f) { unsigned u = __float_as_uint(f); return (u + 0x7fffu + ((u >> 16) & 1u)) >> 16; }
__device__ __forceinline__ unsigned pk2(float lo, float hi) { return f2bf(lo) | (f2bf(hi) << 16); }
__device__ __forceinline__ float wave_sum(float v) {
#pragma unroll
    for (int o = 1; o < 64; o <<= 1) v += __shfl_xor(v, o);
    return v;
}
__device__ __forceinline__ float wave_max(float v) {
#pragma unroll
    for (int o = 1; o < 64; o <<= 1) v = fmaxf(v, __shfl_xor(v, o));
    return v;
}
__device__ __forceinline__ float sigmoidf_(float v) { return 1.0f / (1.0f + __expf(-v)); }
__device__ __forceinline__ float siluf_(float v) { return v / (1.0f + __expf(-v)); }
__device__ __forceinline__ float dot8(u32x4 a, u32x4 b, float acc) {
    acc = fmaf(bflo(a.x), bflo(b.x), acc); acc = fmaf(bfhi(a.x), bfhi(b.x), acc);
    acc = fmaf(bflo(a.y), bflo(b.y), acc); acc = fmaf(bfhi(a.y), bfhi(b.y), acc);
    acc = fmaf(bflo(a.z), bflo(b.z), acc); acc = fmaf(bfhi(a.z), bfhi(b.z), acc);
    acc = fmaf(bflo(a.w), bflo(b.w), acc); acc = fmaf(bfhi(a.w), bfhi(b.w), acc);
    return acc;
}
__device__ __forceinline__ float ssq8(u32x4 a, float acc) { return dot8(a, a, acc); }
#define LDS_WAIT() asm volatile("s_waitcnt lgkmcnt(0)" ::: "memory")

#define XB_TMO      128
#define XB_XCNT(j)  (256  + 64 * (j))
#define XB_XSUB(j)  (1280 + 64 * (j))
#define XB_XGEN(j)  (2304 + 64 * (j))
#define XB_TOP      3328
#define XB_TOPGEN   3392
#define XCD_BAR_WORDS 3456
#define XB_SPIN_CAP (1u << 18)
__device__ __forceinline__ unsigned xb_ld(unsigned* p)              { return __hip_atomic_load(p, __ATOMIC_RELAXED, __HIP_MEMORY_SCOPE_AGENT); }
__device__ __forceinline__ unsigned xb_add(unsigned* p, unsigned v) { return __hip_atomic_fetch_add(p, v, __ATOMIC_RELAXED, __HIP_MEMORY_SCOPE_AGENT); }
__device__ __forceinline__ unsigned xb_xcc_id() { return (unsigned)__builtin_amdgcn_s_getreg((3 << 11) | 20) & 0xFu; }
#define XB_SPIN(cond, bar) do { unsigned _sp = 0; while (cond) { __builtin_amdgcn_s_sleep(1); \
    if ((++_sp & 255u) == 0u) { if (xb_ld(&(bar)[XB_TMO])) break; if (_sp > XB_SPIN_CAP) { atomicAdd(&(bar)[XB_TMO], 1u); break; } } } } while (0)
struct XcdBarrier { unsigned* bar; unsigned x; volatile LAS unsigned* st; };
__device__ __forceinline__ XcdBarrier xcd_barrier_post(unsigned* bar, volatile LAS unsigned* st) {
    XcdBarrier b; b.bar = bar; b.x = xb_xcc_id(); b.st = st;
    if (threadIdx.x == 0) (void)xb_add(&bar[XB_XCNT(b.x)], 1u);
    return b;
}
__device__ __forceinline__ void xcd_barrier_complete(unsigned* bar, unsigned x, unsigned& nloc, unsigned& nx) {
    const unsigned G = gridDim.x * gridDim.y * gridDim.z;
    unsigned sum, cnt, mine, sp = 0u;
    for (;;) {
        sum = 0u; cnt = 0u; mine = 0u;
#pragma unroll
        for (unsigned j = 0; j < 16; ++j) { const unsigned c = xb_ld(&bar[XB_XCNT(j)]); sum += c; cnt += (c > 0u) ? 1u : 0u; mine = (j == x) ? c : mine; }
        if (sum == G) break;
        __builtin_amdgcn_s_sleep(1);
        if ((++sp & 255u) == 0u) { if (xb_ld(&bar[XB_TMO])) break; if (sp > XB_SPIN_CAP) { atomicAdd(&bar[XB_TMO], 1u); break; } }
    }
    nloc = mine > 0u ? mine : 1u; nx = cnt > 0u ? cnt : 1u;
}
__device__ __forceinline__ void xcd_barrier(const XcdBarrier& b) {
    asm volatile("s_waitcnt vmcnt(0)" ::: "memory");
    __syncthreads();
    if (threadIdx.x == 0) {
        unsigned* bar = b.bar;
        __builtin_amdgcn_s_waitcnt(0);
        unsigned nloc = b.st[0], nx = b.st[1];
        if (nloc == 0u) { xcd_barrier_complete(bar, b.x, nloc, nx); b.st[0] = nloc; b.st[1] = nx; }
        const unsigned old = xb_add(&bar[XB_XSUB(b.x)], 1u);
        const unsigned gen = old / nloc;
        if (old + 1u == (gen + 1u) * nloc) {
            __builtin_amdgcn_fence(__ATOMIC_RELEASE, "agent");
            asm volatile("s_waitcnt vmcnt(0)" ::: "memory");
            const unsigned og = xb_add(&bar[XB_TOP], 1u);
            const unsigned tg = og / nx;
            if (og + 1u == (tg + 1u) * nx) xb_add(&bar[XB_TOPGEN], 1u);
            else XB_SPIN(xb_ld(&bar[XB_TOPGEN]) == tg, bar);
            __builtin_amdgcn_fence(__ATOMIC_ACQUIRE, "agent");
            xb_add(&bar[XB_XGEN(b.x)], 1u);
            asm volatile("s_waitcnt vmcnt(0)" ::: "memory");
        } else {
            XB_SPIN(xb_ld(&bar[XB_XGEN(b.x)]) == gen, bar);
            __builtin_amdgcn_fence(__ATOMIC_ACQUIRE, "agent");
            asm volatile("s_waitcnt vmcnt(0)" ::: "memory");
        }
    }
    __syncthreads();
}

struct Args {
    const float* in[18];
    float* out;
    unsigned char* ws;
    int ph_lo, ph_hi;
};

__device__ __forceinline__ void p0_transpose_item(const float* W, int K, int N, const float* g0, const float* g1, int ksplit,
                                                  bf16_t* WT, LAS float* scr, int item, int lane) {
    const int nblk = N / 32, kb = item / nblk, nb = item % nblk, k0 = 64 * kb, n0 = 32 * nb;
#pragma unroll 8
    for (int i = 0; i < 32; ++i) {
        const int kk = 2 * i + (lane >> 5), k = k0 + kk;
        float gv = 1.0f;
        if (g0) gv = (k < ksplit) ? g0[k] : g1[k - ksplit];
        scr[kk * 33 + (lane & 31)] = W[(size_t)k * N + n0 + (lane & 31)] * gv;
    }
    LDS_WAIT();
    const int c = lane & 7;
#pragma unroll
    for (int j = 0; j < 4; ++j) {
        const int n = (lane >> 3) + 8 * j; const LAS float* s = scr + (8 * c) * 33 + n;
        u32x4 o; o.x = pk2(s[0 * 33], s[1 * 33]); o.y = pk2(s[2 * 33], s[3 * 33]); o.z = pk2(s[4 * 33], s[5 * 33]); o.w = pk2(s[6 * 33], s[7 * 33]);
        *(u32x4*)(WT + (size_t)(n0 + n) * K + k0 + 8 * c) = o;
    }
    LDS_WAIT();
}
__device__ __forceinline__ void rope_entry(int pos, int i, float& c, float& s) {
    const int q = i & 3, e = i >> 2;
    double f = (q == 0) ? 1.0 : (q == 1) ? 0.5623413251903491 : (q == 2) ? 0.31622776601683794 : 0.17782794100389228;
    f *= (e == 0) ? 1.0 : (e == 1) ? 0.1 : (e == 2) ? 0.01 : 0.001;
    const float inv = (float)f;
    const float ang = (float)pos * inv;
    const double x = (double)ang;
    const double n = rint(x * 0.15915494309189535);
    const double r = fma(-n, 6.283185307179586, x);
    const double r2 = r * r;
    double sv = 1.0, cv = 1.0;
#pragma unroll
    for (int k = 14; k >= 1; --k) {
        sv = 1.0 - sv * r2 * (1.0 / (double)((2 * k) * (2 * k + 1)));
        cv = 1.0 - cv * r2 * (1.0 / (double)((2 * k - 1) * (2 * k)));
    }
    s = (float)(r * sv); c = (float)cv;
}
__device__ __forceinline__ void phase0(const Args& a, LAS unsigned char* lds, int gw, int NGW, int gt, int NGT, int wave, int lane) {
    unsigned char* ws = a.ws;
    LAS float* scr = (LAS float*)(lds + wave * 8704);
    constexpr int I_IN = (DM / 64) * (INW / 32), I_Q = (256 / 64) * (QW / 32), I_KV = (128 / 64) * (1024 / 32), I_OUT = (1024 / 64) * (1024 / 32), I_G = 8 * 2;
    constexpr int NITEMS = I_IN + I_Q + I_KV + I_OUT + 2 * I_G;
    for (int it = gw; it < NITEMS; it += NGW) {
        int r = it;
        if (r < I_IN) { p0_transpose_item(a.in[2], DM, INW, a.in[1], a.in[1], DM, (bf16_t*)(ws + WS_WIN), scr, r, lane); continue; } r -= I_IN;
        if (r < I_Q) { p0_transpose_item(a.in[4], 256, QW, a.in[3], a.in[3], 256, (bf16_t*)(ws + WS_WQ), scr, r, lane); continue; } r -= I_Q;
        if (r < I_KV) { p0_transpose_item(a.in[6], 128, 1024, a.in[5], a.in[5], 128, (bf16_t*)(ws + WS_WKV), scr, r, lane); continue; } r -= I_KV;
        if (r < I_OUT) { p0_transpose_item(a.in[16], 1024, 1024, a.in[14], a.in[15], 512, (bf16_t*)(ws + WS_WOUT), scr, r, lane); continue; } r -= I_OUT;
        if (r < I_G) { const int n = r >> 1; p0_transpose_item(a.in[9] + n * 4096, 64, 64, nullptr, nullptr, 0, (bf16_t*)(ws + WS_WGA) + n * 4096, scr, r & 1, lane); continue; } r -= I_G;
        { const int n = r >> 1; p0_transpose_item(a.in[11] + n * 4096, 64, 64, nullptr, nullptr, 0, (bf16_t*)(ws + WS_WGX) + n * 4096, scr, r & 1, lane); }
    }
    for (int i = gt; i < (NZ - INW) * DM / 8; i += NGT) ((u32x4*)(ws + WS_WIN + (size_t)INW * DM * 2))[i] = (u32x4){0u, 0u, 0u, 0u};
    for (int i = gt; i < S * 16; i += NGT) { float c, s; rope_entry(i >> 4, i & 15, c, s); ((float2*)(ws + WS_ROPE))[i] = make_float2(c, s); }
    for (int i = gt; i < RW; i += NGT) {
        const float x = __expf(-a.in[13][i]);
        const float sp = x * (1.0f - x * (0.5f - x * (1.0f / 3.0f - x * (0.25f - x * 0.2f))));
        ((float*)(ws + WS_SP))[i] = sp;
    }
    const float* x = a.in[0];
    for (int m = gw; m < T; m += NGW) {
        const f32x4* xr = (const f32x4*)(x + (size_t)m * DM) + lane;
        f32x4 v[4]; float s = 0.f;
#pragma unroll
        for (int j = 0; j < 4; ++j) { v[j] = xr[64 * j]; s += (v[j].x * v[j].x + v[j].y * v[j].y) + (v[j].z * v[j].z + v[j].w * v[j].w); }
        s = wave_sum(s);
        if (lane == 0) ((float*)(ws + WS_RSX))[m] = 1.0f / sqrtf(s * (1.0f / DM) + EPS);
        u32x2* o = (u32x2*)(ws + WS_XB + (size_t)m * DM * 2) + lane;
#pragma unroll
        for (int j = 0; j < 4; ++j) o[64 * j] = (u32x2){pk2(v[j].x, v[j].y), pk2(v[j].z, v[j].w)};
    }
}

__device__ __forceinline__ void phase1_simple(const Args& a, int gt, int NGT) {
    unsigned char* ws = a.ws;
    const bf16_t* XB = (const bf16_t*)(ws + WS_XB); const bf16_t* W = (const bf16_t*)(ws + WS_WIN); const float* RSX = (const float*)(ws + WS_RSX);
    bf16_t* Z = (bf16_t*)(ws + WS_Z);
    for (size_t idx = gt; idx < (size_t)T * NZ; idx += NGT) {
        const int row = (int)(idx >> 11), col = (int)(idx & 2047);
        const u32x4* ap = (const u32x4*)(XB + (size_t)row * DM); const u32x4* bp = (const u32x4*)(W + (size_t)col * DM);
        float acc = 0.f;
        for (int k = 0; k < DM / 8; ++k) acc = dot8(ap[k], bp[k], acc);
        Z[idx] = (bf16_t)f2bf(acc * RSX[row]);
    }
}

__device__ __forceinline__ void phase2_simple(const Args& a, LAS unsigned char* lds, int gt, int NGT, int tid) {
    unsigned char* ws = a.ws;
    const bf16_t* Z = (const bf16_t*)(ws + WS_Z);
    const float2* ROPE = (const float2*)(ws + WS_ROPE);
    bf16_t* Q = (bf16_t*)(ws + WS_Q); bf16_t* K = (bf16_t*)(ws + WS_K); bf16_t* VT = (bf16_t*)(ws + WS_VT);
    {
        const bf16_t* WQ = (const bf16_t*)(ws + WS_WQ);
        for (size_t idx = gt; idx < (size_t)T * NH * 80; idx += NGT) {
            const int row = (int)(idx / (NH * 80)), rem = (int)(idx % (NH * 80)), h = rem / 80, j = rem % 80;
            const u32x4* zp = (const u32x4*)(Z + (size_t)row * NZ + OQ);
            float ss = 0.f;
            for (int k = 0; k < 32; ++k) ss = ssq8(zp[k], ss);
            const float rstd = 1.0f / sqrtf(ss * (1.0f / 256.0f) + EPS);
            if (j < 64) {
                const u32x4* wp = (const u32x4*)(WQ + (size_t)(h * DQK + j) * 256);
                float acc = 0.f;
                for (int k = 0; k < 32; ++k) acc = dot8(zp[k], wp[k], acc);
                Q[(size_t)row * QW + h * DQK + j] = (bf16_t)f2bf(acc * rstd * QSCALE);
            } else {
                const int i = j - 64;
                const u32x4* w1 = (const u32x4*)(WQ + (size_t)(h * DQK + 64 + i) * 256);
                const u32x4* w2 = (const u32x4*)(WQ + (size_t)(h * DQK + 80 + i) * 256);
                float a1 = 0.f, a2 = 0.f;
                for (int k = 0; k < 32; ++k) { a1 = dot8(zp[k], w1[k], a1); a2 = dot8(zp[k], w2[k], a2); }
                a1 *= rstd; a2 *= rstd;
                const float2 cs = ROPE[(row & (S - 1)) * 16 + i];
                Q[(size_t)row * QW + h * DQK + 64 + i] = (bf16_t)f2bf((a1 * cs.x - a2 * cs.y) * QSCALE);
                Q[(size_t)row * QW + h * DQK + 80 + i] = (bf16_t)f2bf((a2 * cs.x + a1 * cs.y) * QSCALE);
            }
        }
    }
    {
        const bf16_t* WKV = (const bf16_t*)(ws + WS_WKV);
        for (size_t idx = gt; idx < (size_t)T * 1024; idx += NGT) {
            const int row = (int)(idx >> 10), n = (int)(idx & 1023), h = n >> 7, c = n & 127;
            const u32x4* zp = (const u32x4*)(Z + (size_t)row * NZ + OKV);
            const u32x4* wp = (const u32x4*)(WKV + (size_t)n * 128);
            float ss = 0.f, acc = 0.f;
            for (int k = 0; k < 16; ++k) { ss = ssq8(zp[k], ss); acc = dot8(zp[k], wp[k], acc); }
            const float v = acc / sqrtf(ss * (1.0f / 128.0f) + EPS);
            if (c < 64) K[(size_t)row * QW + h * DQK + c] = (bf16_t)f2bf(v);
            else VT[((size_t)((row >> 12) * NH + h) * DV + (c - 64)) * S + (row & (S - 1))] = (bf16_t)f2bf(v);
        }
    }
    for (size_t idx = gt; idx < (size_t)T * 16; idx += NGT) {
        const int row = (int)(idx >> 4), i = (int)(idx & 15);
        const float z1 = bf2f(Z[(size_t)row * NZ + OKR + i]), z2 = bf2f(Z[(size_t)row * NZ + OKR + 16 + i]);
        const float2 cs = ROPE[(row & (S - 1)) * 16 + i];
        const bf16_t o1 = (bf16_t)f2bf(z1 * cs.x - z2 * cs.y), o2 = (bf16_t)f2bf(z2 * cs.x + z1 * cs.y);
#pragma unroll
        for (int h = 0; h < NH; ++h) { K[(size_t)row * QW + h * DQK + 64 + i] = o1; K[(size_t)row * QW + h * DQK + 80 + i] = o2; }
    }
    {
        LAS float* xr = (LAS float*)lds;
        LAS float* As = xr + 4096;
        LAS float* Us = As + 4096;
        const float* cw = a.in[7]; const float* cb = a.in[8];
        const float* wa = a.in[9]; const float* ba = a.in[10]; const float* wx = a.in[11]; const float* bx = a.in[12];
        const float* SP = (const float*)(ws + WS_SP);
        bf16_t* HL = (bf16_t*)(ws + WS_HL); bf16_t* CA = (bf16_t*)(ws + WS_CA);
        float* AE = (float*)(ws + WS_AE); float* HE = (float*)(ws + WS_HE);
        for (int u = blockIdx.x; u < NB * NCH * 8; u += gridDim.x) {
            const int n = u & 7, chunk = (u >> 3) & (NCH - 1), b = u >> 9;
            for (int e = tid; e < 4096; e += 256) {
                const int t = e >> 6, c = e & 63, ch = n * 64 + c, s = chunk * CH + t;
                float acc = cb[ch];
#pragma unroll
                for (int k = 0; k < 4; ++k) { const int sp = s - 3 + k; if (sp >= 0) acc = fmaf(cw[k * RW + ch], bf2f(Z[(size_t)(b * S + sp) * NZ + OXR + ch]), acc); }
                xr[e] = acc;
            }
            __syncthreads();
            {
                const int d = tid & 63, tg = tid >> 6, ch = n * 64 + d;
                const float sp = SP[ch], bav = ba[ch], bxv = bx[ch];
                for (int t = tg * 16; t < tg * 16 + 16; ++t) {
                    float pa = bav, px = bxv;
                    for (int c = 0; c < 64; ++c) { const float xv = xr[t * 64 + c]; pa = fmaf(xv, wa[(n * 64 + c) * 64 + d], pa); px = fmaf(xv, wx[(n * 64 + c) * 64 + d], px); }
                    const float r = sigmoidf_(pa), ig = sigmoidf_(px);
                    const float la = -8.0f * r * sp;
                    const float av = __expf(la);
                    float mult = sqrtf(fmaxf(1.0f - __expf(2.0f * la), 1e-12f));
                    if (chunk == 0 && t == 0) mult = 1.0f;
                    As[t * 64 + d] = av; Us[t * 64 + d] = mult * ig * xr[t * 64 + d];
                }
            }
            __syncthreads();
            if (tid < 64) {
                const int ch = n * 64 + tid;
                float hl = 0.f, ca = 1.f;
                for (int t = 0; t < 64; ++t) {
                    const float av = As[t * 64 + tid];
                    hl = fmaf(av, hl, Us[t * 64 + tid]); ca *= av;
                    const size_t o = (size_t)(b * S + chunk * CH + t) * RW + ch;
                    HL[o] = (bf16_t)f2bf(hl); CA[o] = (bf16_t)f2bf(ca);
                }
                AE[(size_t)(b * NCH + chunk) * RW + ch] = ca; HE[(size_t)(b * NCH + chunk) * RW + ch] = hl;
            }
            __syncthreads();
        }
    }
}

__device__ __forceinline__ void phase3_simple(const Args& a, LAS unsigned char* lds, int gw, int NGW, int gt, int NGT, int wave, int lane) {
    unsigned char* ws = a.ws;
    {
        const float* AE = (const float*)(ws + WS_AE); const float* HE = (const float*)(ws + WS_HE); float* CARRY = (float*)(ws + WS_CARRY);
        for (int i = gt; i < NB * RW; i += NGT) {
            const int b = i >> 9, ch = i & 511; float carry = 0.f;
            for (int c = 0; c < NCH; ++c) { const size_t o = (size_t)(b * NCH + c) * RW + ch; CARRY[o] = carry; carry = fmaf(AE[o], carry, HE[o]); }
        }
    }
    const bf16_t* Q = (const bf16_t*)(ws + WS_Q); const bf16_t* K = (const bf16_t*)(ws + WS_K); const bf16_t* VT = (const bf16_t*)(ws + WS_VT);
    bf16_t* YM = (bf16_t*)(ws + WS_YM);
    LAS float* sc = (LAS float*)(lds + wave * 16384);
    LAS float* qs = (LAS float*)(lds + 65536 + wave * 384);
    for (int item = gw; item < T * NH; item += NGW) {
        const int row = item >> 3, h = item & 7, b = row >> 12, s = row & (S - 1), nk = ((s >> 6) + 1) << 6;
        qs[lane] = bf2f(Q[(size_t)row * QW + h * DQK + lane]);
        if (lane < 32) qs[64 + lane] = bf2f(Q[(size_t)row * QW + h * DQK + 64 + lane]);
        LDS_WAIT();
        float mx = -INFINITY;
        for (int key = lane; key < nk; key += 64) {
            const u32x4* kp = (const u32x4*)(K + (size_t)(b * S + key) * QW + h * DQK);
            float dot = 0.f;
#pragma unroll
            for (int j = 0; j < 12; ++j) {
                const u32x4 v = kp[j];
                dot = fmaf(qs[8 * j + 0], bflo(v.x), dot); dot = fmaf(qs[8 * j + 1], bfhi(v.x), dot);
                dot = fmaf(qs[8 * j + 2], bflo(v.y), dot); dot = fmaf(qs[8 * j + 3], bfhi(v.y), dot);
                dot = fmaf(qs[8 * j + 4], bflo(v.z), dot); dot = fmaf(qs[8 * j + 5], bfhi(v.z), dot);
                dot = fmaf(qs[8 * j + 6], bflo(v.w), dot); dot = fmaf(qs[8 * j + 7], bfhi(v.w), dot);
            }
            sc[key] = dot; mx = fmaxf(mx, dot);
        }
        mx = wave_max(mx);
        float sum = 0.f;
        for (int key = lane; key < nk; key += 64) { const float p = __builtin_amdgcn_exp2f(sc[key] - mx); sc[key] = p; sum += p; }
        sum = wave_sum(sum);
        LDS_WAIT();
        const bf16_t* vrow = VT + ((size_t)(b * NH + h) * DV + lane) * S;
        float o = 0.f;
        for (int key = 0; key < nk; key += 8) {
            const u32x4 v = *(const u32x4*)(vrow + key);
            o = fmaf(sc[key + 0], bflo(v.x), o); o = fmaf(sc[key + 1], bfhi(v.x), o);
            o = fmaf(sc[key + 2], bflo(v.y), o); o = fmaf(sc[key + 3], bfhi(v.y), o);
            o = fmaf(sc[key + 4], bflo(v.z), o); o = fmaf(sc[key + 5], bfhi(v.z), o);
            o = fmaf(sc[key + 6], bflo(v.w), o); o = fmaf(sc[key + 7], bfhi(v.w), o);
        }
        YM[(size_t)row * RW + h * DV + lane] = (bf16_t)f2bf(o / sum);
        LDS_WAIT();
    }
}

__device__ __forceinline__ void phaseY(const Args& a, int gw, int NGW, int lane) {
    unsigned char* ws = a.ws;
    const bf16_t* Z = (const bf16_t*)(ws + WS_Z); const bf16_t* YM = (const bf16_t*)(ws + WS_YM);
    const bf16_t* HL = (const bf16_t*)(ws + WS_HL); const bf16_t* CA = (const bf16_t*)(ws + WS_CA);
    const float* CARRY = (const float*)(ws + WS_CARRY); bf16_t* Y = (bf16_t*)(ws + WS_Y);
    for (int m = gw; m < T; m += NGW) {
        const int b = m >> 12, chunk = (m & (S - 1)) >> 6, k0 = lane * 8;
        const u32x4 ym = *(const u32x4*)(YM + (size_t)m * RW + k0);
        const u32x4 hl = *(const u32x4*)(HL + (size_t)m * RW + k0);
        const u32x4 ca = *(const u32x4*)(CA + (size_t)m * RW + k0);
        const f32x4 c0 = *(const f32x4*)(CARRY + (size_t)(b * NCH + chunk) * RW + k0), c1 = *(const f32x4*)(CARRY + (size_t)(b * NCH + chunk) * RW + k0 + 4);
        const u32x4 gm = *(const u32x4*)(Z + (size_t)m * NZ + OGM + k0);
        const u32x4 gr = *(const u32x4*)(Z + (size_t)m * NZ + OGR + k0);
        float y[8], hh[8];
        y[0] = bflo(ym.x); y[1] = bfhi(ym.x); y[2] = bflo(ym.y); y[3] = bfhi(ym.y); y[4] = bflo(ym.z); y[5] = bfhi(ym.z); y[6] = bflo(ym.w); y[7] = bfhi(ym.w);
        hh[0] = fmaf(bflo(ca.x), c0.x, bflo(hl.x)); hh[1] = fmaf(bfhi(ca.x), c0.y, bfhi(hl.x)); hh[2] = fmaf(bflo(ca.y), c0.z, bflo(hl.y)); hh[3] = fmaf(bfhi(ca.y), c0.w, bfhi(hl.y));
        hh[4] = fmaf(bflo(ca.z), c1.x, bflo(hl.z)); hh[5] = fmaf(bfhi(ca.z), c1.y, bfhi(hl.z)); hh[6] = fmaf(bflo(ca.w), c1.z, bflo(hl.w)); hh[7] = fmaf(bfhi(ca.w), c1.w, bfhi(hl.w));
        float s1 = 0.f, s2 = 0.f;
#pragma unroll
        for (int j = 0; j < 8; ++j) { s1 = fmaf(y[j], y[j], s1); s2 = fmaf(hh[j], hh[j], s2); }
        s1 = wave_sum(s1); s2 = wave_sum(s2);
        const float r1 = 1.0f / sqrtf(s1 * (1.0f / RW) + EPS), r2 = 1.0f / sqrtf(s2 * (1.0f / RW) + EPS);
        float g1[8], g2[8];
        g1[0] = bflo(gm.x); g1[1] = bfhi(gm.x); g1[2] = bflo(gm.y); g1[3] = bfhi(gm.y); g1[4] = bflo(gm.z); g1[5] = bfhi(gm.z); g1[6] = bflo(gm.w); g1[7] = bfhi(gm.w);
        g2[0] = bflo(gr.x); g2[1] = bfhi(gr.x); g2[2] = bflo(gr.y); g2[3] = bfhi(gr.y); g2[4] = bflo(gr.z); g2[5] = bfhi(gr.z); g2[6] = bflo(gr.w); g2[7] = bfhi(gr.w);
#pragma unroll
        for (int j = 0; j < 8; ++j) { y[j] = y[j] * r1 * siluf_(g1[j]); hh[j] = hh[j] * r2 * siluf_(g2[j]); }
        *(u32x4*)(Y + (size_t)m * DM + k0) = (u32x4){pk2(y[0], y[1]), pk2(y[2], y[3]), pk2(y[4], y[5]), pk2(y[6], y[7])};
        *(u32x4*)(Y + (size_t)m * DM + RW + k0) = (u32x4){pk2(hh[0], hh[1]), pk2(hh[2], hh[3]), pk2(hh[4], hh[5]), pk2(hh[6], hh[7])};
    }
}

__device__ __forceinline__ void phase4_simple(const Args& a, int gt, int NGT) {
    unsigned char* ws = a.ws;
    const bf16_t* Y = (const bf16_t*)(ws + WS_Y); const bf16_t* W = (const bf16_t*)(ws + WS_WOUT); const float* x = a.in[0];
    for (size_t idx = gt; idx < (size_t)T * DM; idx += NGT) {
        const int row = (int)(idx >> 10), col = (int)(idx & 1023);
        const u32x4* ap = (const u32x4*)(Y + (size_t)row * DM); const u32x4* bp = (const u32x4*)(W + (size_t)col * DM);
        float acc = 0.f;
        for (int k = 0; k < DM / 8; ++k) acc = dot8(ap[k], bp[k], acc);
        a.out[idx] = x[idx] + acc;
    }
}

__device__ __forceinline__ void phase5(const Args& a, int gw, int NGW, int lane) {
    const float* g = a.in[17];
    for (int m = gw; m < T; m += NGW) {
        f32x4* xr = (f32x4*)(a.out + (size_t)m * DM) + lane;
        f32x4 v[4]; float s = 0.f;
#pragma unroll
        for (int j = 0; j < 4; ++j) { v[j] = xr[64 * j]; s += (v[j].x * v[j].x + v[j].y * v[j].y) + (v[j].z * v[j].z + v[j].w * v[j].w); }
        s = wave_sum(s);
        const float rstd = 1.0f / sqrtf(s * (1.0f / DM) + EPS);
#pragma unroll
        for (int j = 0; j < 4; ++j) { const f32x4 gv = ((const f32x4*)g)[lane + 64 * j]; xr[64 * j] = v[j] * rstd * gv; }
    }
}

__global__ void __launch_bounds__(256, 2) mega(Args a) {
    extern __shared__ __attribute__((aligned(16))) unsigned char lds_raw[];
    LAS unsigned char* lds = (LAS unsigned char*)lds_raw;
    volatile LAS unsigned* MISC = (volatile LAS unsigned*)(lds + LDS_MISC);
    const int tid = threadIdx.x, lane = tid & 63, wave = __builtin_amdgcn_readfirstlane(tid >> 6);
    const int G = gridDim.x, NGW = G * 4, gw = blockIdx.x * 4 + wave, NGT = G * 256, gt = blockIdx.x * 256 + tid;
    if (tid < 16) MISC[tid] = 0u;
    __syncthreads();
    XcdBarrier bar; bar.bar = (unsigned*)(a.ws + WS_BAR); bar.x = 0; bar.st = nullptr;
#if MK_LAUNCHES == 1
    bar = xcd_barrier_post((unsigned*)(a.ws + WS_BAR), MISC + 8);
#define SEAM() xcd_barrier(bar)
#else
#define SEAM() do {} while (0)
#endif
    const int lo = a.ph_lo, hi = a.ph_hi;
#define IN(k) (lo <= (k) && (k) < hi)
#define BOTH(k) (IN(k) && IN((k) + 1))
    if (IN(0)) { phase0(a, lds, gw, NGW, gt, NGT, wave, lane); if (BOTH(0)) SEAM(); }
    if (IN(1)) { phase1_simple(a, gt, NGT); if (BOTH(1)) SEAM(); }
    if (IN(2)) { phase2_simple(a, lds, gt, NGT, tid); if (BOTH(2)) SEAM(); }
    if (IN(3)) { phase3_simple(a, lds, gw, NGW, gt, NGT, wave, lane); if (BOTH(3)) SEAM(); }
    if (IN(4)) { phaseY(a, gw, NGW, lane); if (BOTH(4)) SEAM(); }
    if (IN(5)) { phase4_simple(a, gt, NGT); if (BOTH(5)) SEAM(); }
    if (IN(6)) { phase5(a, gw, NGW, lane); }
}

extern "C" void kernel_launch(void* const* d_in, const int* in_sizes, int n_in, void* d_out, int out_size, void* d_ws, size_t ws_size, hipStream_t stream) {
    static int grid = 0;
    if (grid == 0) {
        if (n_in != 18 || in_sizes[0] != T * DM || out_size != T * DM || ws_size < WS_END) { fprintf(stderr, "kernel_launch: unexpected shapes (n_in %d, ws %zu)\n", n_in, ws_size); grid = -1; return; }
        int dev = 0, cus = 0, per_cu = 0;
        (void)hipGetDevice(&dev);
        (void)hipDeviceGetAttribute(&cus, hipDeviceAttributeMultiprocessorCount, dev);
        (void)hipFuncSetAttribute((const void*)mega, hipFuncAttributeMaxDynamicSharedMemorySize, LDS_BYTES);
        if (hipOccupancyMaxActiveBlocksPerMultiprocessor(&per_cu, (const void*)mega, 256, LDS_BYTES) != hipSuccess || per_cu < 1) { fprintf(stderr, "kernel_launch: occupancy query failed (%d)\n", per_cu); per_cu = 1; }
        (void)hipGetLastError();
        if (per_cu > 2) per_cu = 2;
        grid = cus * per_cu;
        fprintf(stderr, "kernel_launch: %d CUs x %d blocks\n", cus, per_cu);
    }
    if (grid < 0) return;
    Args a{};
    for (int i = 0; i < 18; ++i) a.in[i] = (const float*)d_in[i];
    a.out = (float*)d_out; a.ws = (unsigned char*)d_ws;
#if MK_LAUNCHES == 1
    (void)hipMemsetAsync((char*)d_ws + WS_BAR, 0, 16384, stream);
    a.ph_lo = 0; a.ph_hi = NPHASE;
    void* args[] = {&a};
    hipError_t e = hipLaunchCooperativeKernel((const void*)mega, dim3(grid), dim3(256), args, LDS_BYTES, stream);
    if (e != hipSuccess) fprintf(stderr, "cooperative launch failed: %s (grid %d)\n", hipGetErrorString(e), grid);
#else
    for (int p = 0; p < NPHASE; ++p) {
        a.ph_lo = p; a.ph_hi = p + 1;
        hipLaunchKernelGGL(mega, dim3(grid), dim3(256), LDS_BYTES, stream, a);
    }
#endif
}
```

```cpp
#include <hip/hip_runtime.h>
#include <cstdio>
#include <cstdint>

#ifndef MK_LAUNCHES
#define MK_LAUNCHES 1
#endif

#ifndef OPT_GEMM
#define OPT_GEMM 1
#endif

#define LAS __attribute__((address_space(3)))
typedef unsigned short bf16_t;
typedef short bf16x8 __attribute__((ext_vector_type(8)));
typedef unsigned u32x4 __attribute__((ext_vector_type(4)));
typedef unsigned u32x2 __attribute__((ext_vector_type(2)));
typedef float f32x4 __attribute__((ext_vector_type(4)));

constexpr int NB = 4, S = 4096, T = NB * S, DM = 1024;
constexpr int NZ = 2048, INW = 1952;
constexpr int OQ = 0, OKV = 256, OKR = 384, OGM = 416, OXR = 928, OGR = 1440;
constexpr int NH = 8, DQK = 96, DNOPE = 64, DROPE = 32, DV = 64;
constexpr int QW = NH * DQK;
constexpr int RW = 512, CH = 64, NCH = S / CH;
constexpr float EPS = 1e-6f;
constexpr float QSCALE = 0.10206207261596575f * 1.4426950408889634f;
constexpr int NPHASE = 7;

constexpr size_t MiB = 1u << 20;
constexpr size_t WS_BAR = 0;
constexpr size_t WS_WIN = 1 * MiB;
constexpr size_t WS_WQ = 5 * MiB;
constexpr size_t WS_WKV = 5 * MiB + 512 * 1024;
constexpr size_t WS_WOUT = 6 * MiB;
constexpr size_t WS_WGA = 8 * MiB;
constexpr size_t WS_WGX = 8 * MiB + 64 * 1024;
constexpr size_t WS_ROPE = 8 * MiB + 256 * 1024;
constexpr size_t WS_RSX = 9 * MiB;
constexpr size_t WS_SP = 9 * MiB + 128 * 1024;
constexpr size_t WS_XB = 16 * MiB;
constexpr size_t WS_Y = 16 * MiB;
constexpr size_t WS_Z = 48 * MiB;
constexpr size_t WS_Q = 112 * MiB;
constexpr size_t WS_K = 136 * MiB;
constexpr size_t WS_VT = 160 * MiB;
constexpr size_t WS_YM = 176 * MiB;
constexpr size_t WS_HL = 192 * MiB;
constexpr size_t WS_CA = 208 * MiB;
constexpr size_t WS_AE = 224 * MiB;
constexpr size_t WS_HE = 225 * MiB;
constexpr size_t WS_CARRY = 226 * MiB;
constexpr size_t WS_END = 227 * MiB;

constexpr int LDS_MAIN = 68 * 1024;
constexpr int LDS_MISC = LDS_MAIN;
constexpr int LDS_BYTES = LDS_MAIN + 64;

__device__ __forceinline__ float bf2f(unsigned u16) { return __uint_as_float(u16 << 16); }
__device__ __forceinline__ float bflo(unsigned w) { return __uint_as_float(w << 16); }
__device__ __forceinline__ float bfhi(unsigned w) { return __uint_as_float(w & 0xffff0000u); }
__device__ __forceinline__ unsigned f2bf(float f) { unsigned u = __float_as_uint(f); return (u + 0x7fffu + ((u >> 16) & 1u)) >> 16; }
__device__ __forceinline__ unsigned pk2(float lo, float hi) { return f2bf(lo) | (f2bf(hi) << 16); }
__device__ __forceinline__ float wave_sum(float v) {
#pragma unroll
    for (int o = 1; o < 64; o <<= 1) v += __shfl_xor(v, o);
    return v;
}
__device__ __forceinline__ float wave_max(float v) {
#pragma unroll
    for (int o = 1; o < 64; o <<= 1) v = fmaxf(v, __shfl_xor(v, o));
    return v;
}
__device__ __forceinline__ float sigmoidf_(float v) { return 1.0f / (1.0f + __expf(-v)); }
__device__ __forceinline__ float siluf_(float v) { return v / (1.0f + __expf(-v)); }
__device__ __forceinline__ float dot8(u32x4 a, u32x4 b, float acc) {
    acc = fmaf(bflo(a.x), bflo(b.x), acc); acc = fmaf(bfhi(a.x), bfhi(b.x), acc);
    acc = fmaf(bflo(a.y), bflo(b.y), acc); acc = fmaf(bfhi(a.y), bfhi(b.y), acc);
    acc = fmaf(bflo(a.z), bflo(b.z), acc); acc = fmaf(bfhi(a.z), bfhi(b.z), acc);
    acc = fmaf(bflo(a.w), bflo(b.w), acc); acc = fmaf(bfhi(a.w), bfhi(b.w), acc);
    return acc;
}
__device__ __forceinline__ float ssq8(u32x4 a, float acc) { return dot8(a, a, acc); }
#define LDS_WAIT() asm volatile("s_waitcnt lgkmcnt(0)" ::: "memory")

#define XB_TMO      128
#define XB_XCNT(j)  (256  + 64 * (j))
#define XB_XSUB(j)  (1280 + 64 * (j))
#define XB_XGEN(j)  (2304 + 64 * (j))
#define XB_TOP      3328
#define XB_TOPGEN   3392
#define XCD_BAR_WORDS 3456
#define XB_SPIN_CAP (1u << 18)
__device__ __forceinline__ unsigned xb_ld(unsigned* p)              { return __hip_atomic_load(p, __ATOMIC_RELAXED, __HIP_MEMORY_SCOPE_AGENT); }
__device__ __forceinline__ unsigned xb_add(unsigned* p, unsigned v) { return __hip_atomic_fetch_add(p, v, __ATOMIC_RELAXED, __HIP_MEMORY_SCOPE_AGENT); }
__device__ __forceinline__ unsigned xb_xcc_id() { return (unsigned)__builtin_amdgcn_s_getreg((3 << 11) | 20) & 0xFu; }
#define XB_SPIN(cond, bar) do { unsigned _sp = 0; while (cond) { __builtin_amdgcn_s_sleep(1); \
    if ((++_sp & 255u) == 0u) { if (xb_ld(&(bar)[XB_TMO])) break; if (_sp > XB_SPIN_CAP) { atomicAdd(&(bar)[XB_TMO], 1u); break; } } } } while (0)
struct XcdBarrier { unsigned* bar; unsigned x; volatile LAS unsigned* st; };
__device__ __forceinline__ XcdBarrier xcd_barrier_post(unsigned* bar, volatile LAS unsigned* st) {
    XcdBarrier b; b.bar = bar; b.x = xb_xcc_id(); b.st = st;
    if (threadIdx.x == 0) (void)xb_add(&bar[XB_XCNT(b.x)], 1u);
    return b;
}
__device__ __forceinline__ void xcd_barrier_complete(unsigned* bar, unsigned x, unsigned& nloc, unsigned& nx) {
    const unsigned G = gridDim.x * gridDim.y * gridDim.z;
    unsigned sum, cnt, mine, sp = 0u;
    for (;;) {
        sum = 0u; cnt = 0u; mine = 0u;
#pragma unroll
        for (unsigned j = 0; j < 16; ++j) { const unsigned c = xb_ld(&bar[XB_XCNT(j)]); sum += c; cnt += (c > 0u) ? 1u : 0u; mine = (j == x) ? c : mine; }
        if (sum == G) break;
        __builtin_amdgcn_s_sleep(1);
        if ((++sp & 255u) == 0u) { if (xb_ld(&bar[XB_TMO])) break; if (sp > XB_SPIN_CAP) { atomicAdd(&bar[XB_TMO], 1u); break; } }
    }
    nloc = mine > 0u ? mine : 1u; nx = cnt > 0u ? cnt : 1u;
}
__device__ __forceinline__ void xcd_barrier(const XcdBarrier& b) {
    asm volatile("s_waitcnt vmcnt(0)" ::: "memory");
    __syncthreads();
    if (threadIdx.x == 0) {
        unsigned* bar = b.bar;
        __builtin_amdgcn_s_waitcnt(0);
        unsigned nloc = b.st[0], nx = b.st[1];
        if (nloc == 0u) { xcd_barrier_complete(bar, b.x, nloc, nx); b.st[0] = nloc; b.st[1] = nx; }
        const unsigned old = xb_add(&bar[XB_XSUB(b.x)], 1u);
        const unsigned gen = old / nloc;
        if (old + 1u == (gen + 1u) * nloc) {
            __builtin_amdgcn_fence(__ATOMIC_RELEASE, "agent");
            asm volatile("s_waitcnt vmcnt(0)" ::: "memory");
            const unsigned og = xb_add(&bar[XB_TOP], 1u);
            const unsigned tg = og / nx;
            if (og + 1u == (tg + 1u) * nx) xb_add(&bar[XB_TOPGEN], 1u);
            else XB_SPIN(xb_ld(&bar[XB_TOPGEN]) == tg, bar);
            __builtin_amdgcn_fence(__ATOMIC_ACQUIRE, "agent");
            xb_add(&bar[XB_XGEN(b.x)], 1u);
            asm volatile("s_waitcnt vmcnt(0)" ::: "memory");
        } else {
            XB_SPIN(xb_ld(&bar[XB_XGEN(b.x)]) == gen, bar);
            __builtin_amdgcn_fence(__ATOMIC_ACQUIRE, "agent");
            asm volatile("s_waitcnt vmcnt(0)" ::: "memory");
        }
    }
    __syncthreads();
}

struct Args {
    const float* in[18];
    float* out;
    unsigned char* ws;
    int ph_lo, ph_hi;
};

__device__ __forceinline__ void p0_transpose_item(const float* W, int K, int N, const float* g0, const float* g1, int ksplit,
                                                  bf16_t* WT, LAS float* scr, int item, int lane, int kvmap = 0) {
    const int nblk = N / 32, kb = item / nblk, nb = item % nblk, k0 = 64 * kb, n0 = 32 * nb;
#pragma unroll 8
    for (int i = 0; i < 32; ++i) {
        const int kk = 2 * i + (lane >> 5), k = k0 + kk;
        float gv = 1.0f;
        if (g0) gv = (k < ksplit) ? g0[k] : g1[k - ksplit];
        scr[kk * 33 + (lane & 31)] = W[(size_t)k * N + n0 + (lane & 31)] * gv;
    }
    LDS_WAIT();
    const int c = lane & 7;
#pragma unroll
    for (int j = 0; j < 4; ++j) {
        const int n = (lane >> 3) + 8 * j; const LAS float* s = scr + (8 * c) * 33 + n;
        u32x4 o; o.x = pk2(s[0 * 33], s[1 * 33]); o.y = pk2(s[2 * 33], s[3 * 33]); o.z = pk2(s[4 * 33], s[5 * 33]); o.w = pk2(s[6 * 33], s[7 * 33]);
        int nd = n0 + n;
        if (kvmap) { const int h = nd >> 7, cc = nd & 127; nd = (cc < 64) ? h * 64 + cc : 512 + h * 64 + (cc - 64); }
        *(u32x4*)(WT + (size_t)nd * K + k0 + 8 * c) = o;
    }
    LDS_WAIT();
}
__device__ __forceinline__ void rope_entry(int pos, int i, float& c, float& s) {
    const int q = i & 3, e = i >> 2;
    double f = (q == 0) ? 1.0 : (q == 1) ? 0.5623413251903491 : (q == 2) ? 0.31622776601683794 : 0.17782794100389228;
    f *= (e == 0) ? 1.0 : (e == 1) ? 0.1 : (e == 2) ? 0.01 : 0.001;
    const float inv = (float)f;
    const float ang = (float)pos * inv;
    const double x = (double)ang;
    const double n = rint(x * 0.15915494309189535);
    const double r = fma(-n, 6.283185307179586, x);
    const double r2 = r * r;
    double sv = 1.0, cv = 1.0;
#pragma unroll
    for (int k = 14; k >= 1; --k) {
        sv = 1.0 - sv * r2 * (1.0 / (double)((2 * k) * (2 * k + 1)));
        cv = 1.0 - cv * r2 * (1.0 / (double)((2 * k - 1) * (2 * k)));
    }
    s = (float)(r * sv); c = (float)cv;
}
__device__ __forceinline__ void phase0(const Args& a, LAS unsigned char* lds, int gw, int NGW, int gt, int NGT, int wave, int lane) {
    unsigned char* ws = a.ws;
    LAS float* scr = (LAS float*)(lds + wave * 8704);
    constexpr int I_IN = (DM / 64) * (INW / 32), I_Q = (256 / 64) * (QW / 32), I_KV = (128 / 64) * (1024 / 32), I_OUT = (1024 / 64) * (1024 / 32), I_G = 8 * 2;
    constexpr int NITEMS = I_IN + I_Q + I_KV + I_OUT + 2 * I_G;
    for (int it = gw; it < NITEMS; it += NGW) {
        int r = it;
        if (r < I_IN) { p0_transpose_item(a.in[2], DM, INW, a.in[1], a.in[1], DM, (bf16_t*)(ws + WS_WIN), scr, r, lane); continue; } r -= I_IN;
        if (r < I_Q) { p0_transpose_item(a.in[4], 256, QW, a.in[3], a.in[3], 256, (bf16_t*)(ws + WS_WQ), scr, r, lane); continue; } r -= I_Q;
        if (r < I_KV) { p0_transpose_item(a.in[6], 128, 1024, a.in[5], a.in[5], 128, (bf16_t*)(ws + WS_WKV), scr, r, lane, OPT_GEMM); continue; } r -= I_KV;
        if (r < I_OUT) { p0_transpose_item(a.in[16], 1024, 1024, a.in[14], a.in[15], 512, (bf16_t*)(ws + WS_WOUT), scr, r, lane); continue; } r -= I_OUT;
        if (r < I_G) { const int n = r >> 1; p0_transpose_item(a.in[9] + n * 4096, 64, 64, nullptr, nullptr, 0, (bf16_t*)(ws + WS_WGA) + n * 4096, scr, r & 1, lane); continue; } r -= I_G;
        { const int n = r >> 1; p0_transpose_item(a.in[11] + n * 4096, 64, 64, nullptr, nullptr, 0, (bf16_t*)(ws + WS_WGX) + n * 4096, scr, r & 1, lane); }
    }
    for (int i = gt; i < (NZ - INW) * DM / 8; i += NGT) ((u32x4*)(ws + WS_WIN + (size_t)INW * DM * 2))[i] = (u32x4){0u, 0u, 0u, 0u};
    for (int i = gt; i < S * 16; i += NGT) { float c, s; rope_entry(i >> 4, i & 15, c, s); ((float2*)(ws + WS_ROPE))[i] = make_float2(c, s); }
    for (int i = gt; i < RW; i += NGT) {
        const float x = __expf(-a.in[13][i]);
        const float sp = x * (1.0f - x * (0.5f - x * (1.0f / 3.0f - x * (0.25f - x * 0.2f))));
        ((float*)(ws + WS_SP))[i] = sp;
    }
    const float* x = a.in[0];
    for (int m = gw; m < T; m += NGW) {
        const f32x4* xr = (const f32x4*)(x + (size_t)m * DM) + lane;
        f32x4 v[4]; float s = 0.f;
#pragma unroll
        for (int j = 0; j < 4; ++j) { v[j] = xr[64 * j]; s += (v[j].x * v[j].x + v[j].y * v[j].y) + (v[j].z * v[j].z + v[j].w * v[j].w); }
        s = wave_sum(s);
        if (lane == 0) ((float*)(ws + WS_RSX))[m] = 1.0f / sqrtf(s * (1.0f / DM) + EPS);
        u32x2* o = (u32x2*)(ws + WS_XB + (size_t)m * DM * 2) + lane;
#pragma unroll
        for (int j = 0; j < 4; ++j) o[64 * j] = (u32x2){pk2(v[j].x, v[j].y), pk2(v[j].z, v[j].w)};
    }
}

__device__ __forceinline__ int lds_byte(int r, int c) { const int st = (r >> 4) * 2 + (c >> 5), rr = r & 15, cc = c & 31, ob = rr * 64 + cc * 2; return st * 1024 + (ob ^ (((ob >> 9) & 1) << 5)); }
__device__ __forceinline__ void stage_rc(int b, int& R, int& C) { const int st = b / 1024, sb = b % 1024, swz = sb ^ (((sb >> 9) & 1) << 5); R = (st >> 1) * 16 + swz / 64; C = (st & 1) * 32 + (swz % 64) / 2; }
__device__ __forceinline__ float ssq_frag(bf16x8 v, float acc) {
#pragma unroll
    for (int j = 0; j < 8; ++j) { const float f = __uint_as_float(((unsigned)(unsigned short)v[j]) << 16); acc = fmaf(f, f, acc); }
    return acc;
}
template <bool TRANS, bool SSQ, class Epi>
__device__ __forceinline__ void gemm_tile(LAS unsigned char* lds, const bf16_t* A, int lda, const bf16_t* B, int ldb, int nt,
                                          int tid, int wave, int lane, const Epi& epi) {
    const int wr = wave >> 1, wc = wave & 1, fr = lane & 15, fq = lane >> 4;
    unsigned voffA[4], voffB[4];
#pragma unroll
    for (int i = 0; i < 4; ++i) { int R, C; stage_rc(tid * 16 + i * 4096, R, C); voffA[i] = (unsigned)(R * lda + C) * 2u; voffB[i] = (unsigned)(R * ldb + C) * 2u; }
    const unsigned ldsw = (unsigned)wave * 1024u;
    const int aoff = lds_byte(wr * 64 + fr, fq * 8), boff = lds_byte(wc * 64 + fr, fq * 8);
#define GT_STAGE(t, b) do { _Pragma("unroll") for (int _i = 0; _i < 4; ++_i) { \
        __builtin_amdgcn_global_load_lds((const unsigned*)((const char*)A + voffA[_i] + (size_t)(t) * 128), (LAS unsigned*)(lds + (b) * 32768 + _i * 4096 + ldsw), 16, 0, 0); \
        __builtin_amdgcn_global_load_lds((const unsigned*)((const char*)B + voffB[_i] + (size_t)(t) * 128), (LAS unsigned*)(lds + (b) * 32768 + 16384 + _i * 4096 + ldsw), 16, 0, 0); } } while (0)
    f32x4 acc[4][4];
#pragma unroll
    for (int m = 0; m < 4; ++m)
#pragma unroll
        for (int n = 0; n < 4; ++n) acc[m][n] = (f32x4){0.f, 0.f, 0.f, 0.f};
    float ssq[4] = {0.f, 0.f, 0.f, 0.f};
    GT_STAGE(0, 0);
    for (int t = 0; t < nt; ++t) {
        asm volatile("s_waitcnt vmcnt(0)" ::: "memory"); __builtin_amdgcn_s_barrier(); asm volatile("" ::: "memory");
        if (t + 1 < nt) GT_STAGE(t + 1, (t + 1) & 1);
        const LAS unsigned char* bufA = lds + (t & 1) * 32768; const LAS unsigned char* bufB = bufA + 16384;
        bf16x8 af[4][2], bfr[4][2];
#pragma unroll
        for (int m = 0; m < 4; ++m)
#pragma unroll
            for (int k = 0; k < 2; ++k) af[m][k] = *(const LAS bf16x8*)(bufA + aoff + m * 2048 + k * 1024);
#pragma unroll
        for (int n = 0; n < 4; ++n)
#pragma unroll
            for (int k = 0; k < 2; ++k) bfr[n][k] = *(const LAS bf16x8*)(bufB + boff + n * 2048 + k * 1024);
        if (SSQ) {
#pragma unroll
            for (int m = 0; m < 4; ++m) { ssq[m] = ssq_frag(af[m][0], ssq[m]); ssq[m] = ssq_frag(af[m][1], ssq[m]); }
        }
#pragma unroll
        for (int k = 0; k < 2; ++k)
#pragma unroll
            for (int m = 0; m < 4; ++m)
#pragma unroll
                for (int n = 0; n < 4; ++n)
                    acc[m][n] = TRANS ? __builtin_amdgcn_mfma_f32_16x16x32_bf16(bfr[n][k], af[m][k], acc[m][n], 0, 0, 0)
                                      : __builtin_amdgcn_mfma_f32_16x16x32_bf16(af[m][k], bfr[n][k], acc[m][n], 0, 0, 0);
    }
    if (SSQ) {
#pragma unroll
        for (int m = 0; m < 4; ++m) { ssq[m] += __shfl_xor(ssq[m], 16); ssq[m] += __shfl_xor(ssq[m], 32); }
    }
    epi(acc, ssq, wr * 64, wc * 64, fr, fq);
#undef GT_STAGE
}
struct UnitOrder {
    int G, v, ntn, nunits;
    __device__ __forceinline__ void init(int G_, int bx, int ntn_, int nunits_) { G = G_; ntn = ntn_; nunits = nunits_; v = (G_ % 8 == 0) ? (bx % 8) * (G_ / 8) + bx / 8 : bx; }
    __device__ __forceinline__ bool next(int i, int& pm, int& pn) const { const int L = i * G + v; if (L >= nunits) return false; pm = L / ntn; pn = L % ntn; return true; }
};

struct EpiZ {
    bf16_t* Z; const float* RSX; int row0, col0;
    __device__ __forceinline__ void operator()(const f32x4 (&acc)[4][4], const float (&)[4], int wrow, int wcol, int fr, int fq) const {
#pragma unroll
        for (int m = 0; m < 4; ++m) {
            const int row = row0 + wrow + m * 16 + fr; const float rs = RSX[row];
#pragma unroll
            for (int n = 0; n < 4; ++n) { const f32x4 v = acc[m][n] * rs; *(u32x2*)(Z + (size_t)row * NZ + col0 + wcol + n * 16 + 4 * fq) = (u32x2){pk2(v.x, v.y), pk2(v.z, v.w)}; }
        }
    }
};
struct EpiOut {
    float* out; const float* x; int row0, col0;
    __device__ __forceinline__ void operator()(const f32x4 (&acc)[4][4], const float (&)[4], int wrow, int wcol, int fr, int fq) const {
#pragma unroll
        for (int m = 0; m < 4; ++m) {
            const int row = row0 + wrow + m * 16 + fr;
#pragma unroll
            for (int n = 0; n < 4; ++n) { const size_t o = (size_t)row * DM + col0 + wcol + n * 16 + 4 * fq; *(f32x4*)(out + o) = *(const f32x4*)(x + o) + acc[m][n]; }
        }
    }
};
struct EpiQ {
    bf16_t* Q; const float2* ROPE; int row0, col0;
    __device__ __forceinline__ void operator()(const f32x4 (&acc)[4][4], const float (&ssq)[4], int wrow, int wcol, int fr, int fq) const {
#pragma unroll
        for (int m = 0; m < 4; ++m) {
            const int row = row0 + wrow + m * 16 + fr; const float rs = QSCALE / sqrtf(ssq[m] * (1.0f / 256.0f) + EPS);
#pragma unroll
            for (int p = 0; p < 2; ++p) {
                const int c0 = col0 + wcol + p * 32;
                f32x4 v1 = acc[m][2 * p] * rs, v2 = acc[m][2 * p + 1] * rs;
                if (c0 % DQK == DNOPE) {
                    const f32x4* rp = (const f32x4*)(ROPE + (size_t)(row & (S - 1)) * 16 + 4 * fq);
                    const f32x4 r01 = rp[0], r23 = rp[1];
                    const f32x4 cs = (f32x4){r01.x, r01.z, r23.x, r23.z}, sn = (f32x4){r01.y, r01.w, r23.y, r23.w};
                    const f32x4 o1 = v1 * cs - v2 * sn, o2 = v2 * cs + v1 * sn; v1 = o1; v2 = o2;
                }
                bf16_t* qp = Q + (size_t)row * QW + c0 + 4 * fq;
                *(u32x2*)qp = (u32x2){pk2(v1.x, v1.y), pk2(v1.z, v1.w)};
                *(u32x2*)(qp + 16) = (u32x2){pk2(v2.x, v2.y), pk2(v2.z, v2.w)};
            }
        }
    }
};
struct EpiKn {
    bf16_t* K; int row0, col0;
    __device__ __forceinline__ void operator()(const f32x4 (&acc)[4][4], const float (&ssq)[4], int wrow, int wcol, int fr, int fq) const {
        const int h = (col0 + wcol) >> 6;
#pragma unroll
        for (int m = 0; m < 4; ++m) {
            const int row = row0 + wrow + m * 16 + fr; const float rs = 1.0f / sqrtf(ssq[m] * (1.0f / 128.0f) + EPS);
#pragma unroll
            for (int n = 0; n < 4; ++n) { const f32x4 v = acc[m][n] * rs; *(u32x2*)(K + (size_t)row * QW + h * DQK + n * 16 + 4 * fq) = (u32x2){pk2(v.x, v.y), pk2(v.z, v.w)}; }
        }
    }
};
struct EpiVt {
    bf16_t* VT; int row0, col0;
    __device__ __forceinline__ void operator()(const f32x4 (&acc)[4][4], const float (&ssq)[4], int wrow, int wcol, int fr, int fq) const {
        const int h = (col0 + wcol) >> 6;
#pragma unroll
        for (int m = 0; m < 4; ++m) {
            const int r0 = row0 + wrow + m * 16 + 4 * fq, b = r0 >> 12, s0 = r0 & (S - 1);
            f32x4 rs;
#pragma unroll
            for (int j = 0; j < 4; ++j) rs[j] = 1.0f / sqrtf(__shfl(ssq[m], 4 * fq + j) * (1.0f / 128.0f) + EPS);
#pragma unroll
            for (int n = 0; n < 4; ++n) { const f32x4 v = acc[m][n] * rs; *(u32x2*)(VT + ((size_t)(b * NH + h) * DV + n * 16 + fr) * S + s0) = (u32x2){pk2(v.x, v.y), pk2(v.z, v.w)}; }
        }
    }
};

__device__ __forceinline__ void phase1_gemm(const Args& a, LAS unsigned char* lds, int tid, int wave, int lane) {
    unsigned char* ws = a.ws;
    UnitOrder U; U.init(gridDim.x, blockIdx.x, NZ / 128, (T / 128) * (NZ / 128));
    int pm, pn;
    for (int i = 0; U.next(i, pm, pn); ++i) {
        EpiZ E{(bf16_t*)(ws + WS_Z), (const float*)(ws + WS_RSX), pm * 128, pn * 128};
        gemm_tile<true, false>(lds, (const bf16_t*)(ws + WS_XB) + (size_t)pm * 128 * DM, DM, (const bf16_t*)(ws + WS_WIN) + (size_t)pn * 128 * DM, DM, DM / 64, tid, wave, lane, E);
    }
}
__device__ __forceinline__ void phase4_gemm(const Args& a, LAS unsigned char* lds, int tid, int wave, int lane) {
    unsigned char* ws = a.ws;
    UnitOrder U; U.init(gridDim.x, blockIdx.x, DM / 128, (T / 128) * (DM / 128));
    int pm, pn;
    for (int i = 0; U.next(i, pm, pn); ++i) {
        EpiOut E{a.out, a.in[0], pm * 128, pn * 128};
        gemm_tile<true, false>(lds, (const bf16_t*)(ws + WS_Y) + (size_t)pm * 128 * DM, DM, (const bf16_t*)(ws + WS_WOUT) + (size_t)pn * 128 * DM, DM, DM / 64, tid, wave, lane, E);
    }
}
__device__ __forceinline__ void phase2_gemm(const Args& a, LAS unsigned char* lds, int tid, int wave, int lane) {
    unsigned char* ws = a.ws;
    const bf16_t* Z = (const bf16_t*)(ws + WS_Z);
    UnitOrder U; U.init(gridDim.x, blockIdx.x, 14, (T / 128) * 14);
    int pm, pn;
    for (int i = 0; U.next(i, pm, pn); ++i) {
        const bf16_t* Ar = Z + (size_t)pm * 128 * NZ;
        if (pn < 6) {
            EpiQ E{(bf16_t*)(ws + WS_Q), (const float2*)(ws + WS_ROPE), pm * 128, pn * 128};
            gemm_tile<true, true>(lds, Ar + OQ, NZ, (const bf16_t*)(ws + WS_WQ) + (size_t)pn * 128 * 256, 256, 4, tid, wave, lane, E);
        } else if (pn < 10) {
            EpiKn E{(bf16_t*)(ws + WS_K), pm * 128, (pn - 6) * 128};
            gemm_tile<true, true>(lds, Ar + OKV, NZ, (const bf16_t*)(ws + WS_WKV) + (size_t)(pn - 6) * 128 * 128, 128, 2, tid, wave, lane, E);
        } else {
            EpiVt E{(bf16_t*)(ws + WS_VT), pm * 128, (pn - 10) * 128};
            gemm_tile<false, true>(lds, Ar + OKV, NZ, (const bf16_t*)(ws + WS_WKV) + (size_t)(512 + (pn - 10) * 128) * 128, 128, 2, tid, wave, lane, E);
        }
    }
}

__device__ __forceinline__ void phase1_simple(const Args& a, int gt, int NGT) {
    unsigned char* ws = a.ws;
    const bf16_t* XB = (const bf16_t*)(ws + WS_XB); const bf16_t* W = (const bf16_t*)(ws + WS_WIN); const float* RSX = (const float*)(ws + WS_RSX);
    bf16_t* Z = (bf16_t*)(ws + WS_Z);
    for (size_t idx = gt; idx < (size_t)T * NZ; idx += NGT) {
        const int row = (int)(idx >> 11), col = (int)(idx & 2047);
        const u32x4* ap = (const u32x4*)(XB + (size_t)row * DM); const u32x4* bp = (const u32x4*)(W + (size_t)col * DM);
        float acc = 0.f;
        for (int k = 0; k < DM / 8; ++k) acc = dot8(ap[k], bp[k], acc);
        Z[idx] = (bf16_t)f2bf(acc * RSX[row]);
    }
}

__device__ __forceinline__ void phase2_simple(const Args& a, LAS unsigned char* lds, int gt, int NGT, int tid) {
    unsigned char* ws = a.ws;
    const bf16_t* Z = (const bf16_t*)(ws + WS_Z);
    const float2* ROPE = (const float2*)(ws + WS_ROPE);
    bf16_t* Q = (bf16_t*)(ws + WS_Q); bf16_t* K = (bf16_t*)(ws + WS_K); bf16_t* VT = (bf16_t*)(ws + WS_VT);
#if !OPT_GEMM
    {
        const bf16_t* WQ = (const bf16_t*)(ws + WS_WQ);
        for (size_t idx = gt; idx < (size_t)T * NH * 80; idx += NGT) {
            const int row = (int)(idx / (NH * 80)), rem = (int)(idx % (NH * 80)), h = rem / 80, j = rem % 80;
            const u32x4* zp = (const u32x4*)(Z + (size_t)row * NZ + OQ);
            float ss = 0.f;
            for (int k = 0; k < 32; ++k) ss = ssq8(zp[k], ss);
            const float rstd = 1.0f / sqrtf(ss * (1.0f / 256.0f) + EPS);
            if (j < 64) {
                const u32x4* wp = (const u32x4*)(WQ + (size_t)(h * DQK + j) * 256);
                float acc = 0.f;
                for (int k = 0; k < 32; ++k) acc = dot8(zp[k], wp[k], acc);
                Q[(size_t)row * QW + h * DQK + j] = (bf16_t)f2bf(acc * rstd * QSCALE);
            } else {
                const int i = j - 64;
                const u32x4* w1 = (const u32x4*)(WQ + (size_t)(h * DQK + 64 + i) * 256);
                const u32x4* w2 = (const u32x4*)(WQ + (size_t)(h * DQK + 80 + i) * 256);
                float a1 = 0.f, a2 = 0.f;
                for (int k = 0; k < 32; ++k) { a1 = dot8(zp[k], w1[k], a1); a2 = dot8(zp[k], w2[k], a2); }
                a1 *= rstd; a2 *= rstd;
                const float2 cs = ROPE[(row & (S - 1)) * 16 + i];
                Q[(size_t)row * QW + h * DQK + 64 + i] = (bf16_t)f2bf((a1 * cs.x - a2 * cs.y) * QSCALE);
                Q[(size_t)row * QW + h * DQK + 80 + i] = (bf16_t)f2bf((a2 * cs.x + a1 * cs.y) * QSCALE);
            }
        }
    }
    {
        const bf16_t* WKV = (const bf16_t*)(ws + WS_WKV);
        for (size_t idx = gt; idx < (size_t)T * 1024; idx += NGT) {
            const int row = (int)(idx >> 10), n = (int)(idx & 1023), h = n >> 7, c = n & 127;
            const u32x4* zp = (const u32x4*)(Z + (size_t)row * NZ + OKV);
            const u32x4* wp = (const u32x4*)(WKV + (size_t)n * 128);
            float ss = 0.f, acc = 0.f;
            for (int k = 0; k < 16; ++k) { ss = ssq8(zp[k], ss); acc = dot8(zp[k], wp[k], acc); }
            const float v = acc / sqrtf(ss * (1.0f / 128.0f) + EPS);
            if (c < 64) K[(size_t)row * QW + h * DQK + c] = (bf16_t)f2bf(v);
            else VT[((size_t)((row >> 12) * NH + h) * DV + (c - 64)) * S + (row & (S - 1))] = (bf16_t)f2bf(v);
        }
    }
#endif
    for (size_t idx = gt; idx < (size_t)T * 16; idx += NGT) {
        const int row = (int)(idx >> 4), i = (int)(idx & 15);
        const float z1 = bf2f(Z[(size_t)row * NZ + OKR + i]), z2 = bf2f(Z[(size_t)row * NZ + OKR + 16 + i]);
        const float2 cs = ROPE[(row & (S - 1)) * 16 + i];
        const bf16_t o1 = (bf16_t)f2bf(z1 * cs.x - z2 * cs.y), o2 = (bf16_t)f2bf(z2 * cs.x + z1 * cs.y);
#pragma unroll
        for (int h = 0; h < NH; ++h) { K[(size_t)row * QW + h * DQK + 64 + i] = o1; K[(size_t)row * QW + h * DQK + 80 + i] = o2; }
    }
    {
        LAS float* xr = (LAS float*)lds;
        LAS float* As = xr + 4096;
        LAS float* Us = As + 4096;
        const float* cw = a.in[7]; const float* cb = a.in[8];
        const float* wa = a.in[9]; const float* ba = a.in[10]; const float* wx = a.in[11]; const float* bx = a.in[12];
        const float* SP = (const float*)(ws + WS_SP);
        bf16_t* HL = (bf16_t*)(ws + WS_HL); bf16_t* CA = (bf16_t*)(ws + WS_CA);
        float* AE = (float*)(ws + WS_AE); float* HE = (float*)(ws + WS_HE);
        for (int u = blockIdx.x; u < NB * NCH * 8; u += gridDim.x) {
            const int n = u & 7, chunk = (u >> 3) & (NCH - 1), b = u >> 9;
            for (int e = tid; e < 4096; e += 256) {
                const int t = e >> 6, c = e & 63, ch = n * 64 + c, s = chunk * CH + t;
                float acc = cb[ch];
#pragma unroll
                for (int k = 0; k < 4; ++k) { const int sp = s - 3 + k; if (sp >= 0) acc = fmaf(cw[k * RW + ch], bf2f(Z[(size_t)(b * S + sp) * NZ + OXR + ch]), acc); }
                xr[e] = acc;
            }
            __syncthreads();
            {
                const int d = tid & 63, tg = tid >> 6, ch = n * 64 + d;
                const float sp = SP[ch], bav = ba[ch], bxv = bx[ch];
                for (int t = tg * 16; t < tg * 16 + 16; ++t) {
                    float pa = bav, px = bxv;
                    for (int c = 0; c < 64; ++c) { const float xv = xr[t * 64 + c]; pa = fmaf(xv, wa[(n * 64 + c) * 64 + d], pa); px = fmaf(xv, wx[(n * 64 + c) * 64 + d], px); }
                    const float r = sigmoidf_(pa), ig = sigmoidf_(px);
                    const float la = -8.0f * r * sp;
                    const float av = __expf(la);
                    float mult = sqrtf(fmaxf(1.0f - __expf(2.0f * la), 1e-12f));
                    if (chunk == 0 && t == 0) mult = 1.0f;
                    As[t * 64 + d] = av; Us[t * 64 + d] = mult * ig * xr[t * 64 + d];
                }
            }
            __syncthreads();
            if (tid < 64) {
                const int ch = n * 64 + tid;
                float hl = 0.f, ca = 1.f;
                for (int t = 0; t < 64; ++t) {
                    const float av = As[t * 64 + tid];
                    hl = fmaf(av, hl, Us[t * 64 + tid]); ca *= av;
                    const size_t o = (size_t)(b * S + chunk * CH + t) * RW + ch;
                    HL[o] = (bf16_t)f2bf(hl); CA[o] = (bf16_t)f2bf(ca);
                }
                AE[(size_t)(b * NCH + chunk) * RW + ch] = ca; HE[(size_t)(b * NCH + chunk) * RW + ch] = hl;
            }
            __syncthreads();
        }
    }
}

__device__ __forceinline__ void phase3_simple(const Args& a, LAS unsigned char* lds, int gw, int NGW, int gt, int NGT, int wave, int lane) {
    unsigned char* ws = a.ws;
    {
        const float* AE = (const float*)(ws + WS_AE); const float* HE = (const float*)(ws + WS_HE); float* CARRY = (float*)(ws + WS_CARRY);
        for (int i = gt; i < NB * RW; i += NGT) {
            const int b = i >> 9, ch = i & 511; float carry = 0.f;
            for (int c = 0; c < NCH; ++c) { const size_t o = (size_t)(b * NCH + c) * RW + ch; CARRY[o] = carry; carry = fmaf(AE[o], carry, HE[o]); }
        }
    }
    const bf16_t* Q = (const bf16_t*)(ws + WS_Q); const bf16_t* K = (const bf16_t*)(ws + WS_K); const bf16_t* VT = (const bf16_t*)(ws + WS_VT);
    bf16_t* YM = (bf16_t*)(ws + WS_YM);
    LAS float* sc = (LAS float*)(lds + wave * 16384);
    LAS float* qs = (LAS float*)(lds + 65536 + wave * 384);
    for (int item = gw; item < T * NH; item += NGW) {
        const int row = item >> 3, h = item & 7, b = row >> 12, s = row & (S - 1), nk = ((s >> 6) + 1) << 6;
        qs[lane] = bf2f(Q[(size_t)row * QW + h * DQK + lane]);
        if (lane < 32) qs[64 + lane] = bf2f(Q[(size_t)row * QW + h * DQK + 64 + lane]);
        LDS_WAIT();
        float mx = -INFINITY;
        for (int key = lane; key < nk; key += 64) {
            const u32x4* kp = (const u32x4*)(K + (size_t)(b * S + key) * QW + h * DQK);
            float dot = 0.f;
#pragma unroll
            for (int j = 0; j < 12; ++j) {
                const u32x4 v = kp[j];
                dot = fmaf(qs[8 * j + 0], bflo(v.x), dot); dot = fmaf(qs[8 * j + 1], bfhi(v.x), dot);
                dot = fmaf(qs[8 * j + 2], bflo(v.y), dot); dot = fmaf(qs[8 * j + 3], bfhi(v.y), dot);
                dot = fmaf(qs[8 * j + 4], bflo(v.z), dot); dot = fmaf(qs[8 * j + 5], bfhi(v.z), dot);
                dot = fmaf(qs[8 * j + 6], bflo(v.w), dot); dot = fmaf(qs[8 * j + 7], bfhi(v.w), dot);
            }
            sc[key] = dot; mx = fmaxf(mx, dot);
        }
        mx = wave_max(mx);
        float sum = 0.f;
        for (int key = lane; key < nk; key += 64) { const float p = __builtin_amdgcn_exp2f(sc[key] - mx); sc[key] = p; sum += p; }
        sum = wave_sum(sum);
        LDS_WAIT();
        const bf16_t* vrow = VT + ((size_t)(b * NH + h) * DV + lane) * S;
        float o = 0.f;
        for (int key = 0; key < nk; key += 8) {
            const u32x4 v = *(const u32x4*)(vrow + key);
            o = fmaf(sc[key + 0], bflo(v.x), o); o = fmaf(sc[key + 1], bfhi(v.x), o);
            o = fmaf(sc[key + 2], bflo(v.y), o); o = fmaf(sc[key + 3], bfhi(v.y), o);
            o = fmaf(sc[key + 4], bflo(v.z), o); o = fmaf(sc[key + 5], bfhi(v.z), o);
            o = fmaf(sc[key + 6], bflo(v.w), o); o = fmaf(sc[key + 7], bfhi(v.w), o);
        }
        YM[(size_t)row * RW + h * DV + lane] = (bf16_t)f2bf(o / sum);
        LDS_WAIT();
    }
}

__device__ __forceinline__ void phaseY(const Args& a, int gw, int NGW, int lane) {
    unsigned char* ws = a.ws;
    const bf16_t* Z = (const bf16_t*)(ws + WS_Z); const bf16_t* YM = (const bf16_t*)(ws + WS_YM);
    const bf16_t* HL = (const bf16_t*)(ws + WS_HL); const bf16_t* CA = (const bf16_t*)(ws + WS_CA);
    const float* CARRY = (const float*)(ws + WS_CARRY); bf16_t* Y = (bf16_t*)(ws + WS_Y);
    for (int m = gw; m < T; m += NGW) {
        const int b = m >> 12, chunk = (m & (S - 1)) >> 6, k0 = lane * 8;
        const u32x4 ym = *(const u32x4*)(YM + (size_t)m * RW + k0);
        const u32x4 hl = *(const u32x4*)(HL + (size_t)m * RW + k0);
        const u32x4 ca = *(const u32x4*)(CA + (size_t)m * RW + k0);
        const f32x4 c0 = *(const f32x4*)(CARRY + (size_t)(b * NCH + chunk) * RW + k0), c1 = *(const f32x4*)(CARRY + (size_t)(b * NCH + chunk) * RW + k0 + 4);
        const u32x4 gm = *(const u32x4*)(Z + (size_t)m * NZ + OGM + k0);
        const u32x4 gr = *(const u32x4*)(Z + (size_t)m * NZ + OGR + k0);
        float y[8], hh[8];
        y[0] = bflo(ym.x); y[1] = bfhi(ym.x); y[2] = bflo(ym.y); y[3] = bfhi(ym.y); y[4] = bflo(ym.z); y[5] = bfhi(ym.z); y[6] = bflo(ym.w); y[7] = bfhi(ym.w);
        hh[0] = fmaf(bflo(ca.x), c0.x, bflo(hl.x)); hh[1] = fmaf(bfhi(ca.x), c0.y, bfhi(hl.x)); hh[2] = fmaf(bflo(ca.y), c0.z, bflo(hl.y)); hh[3] = fmaf(bfhi(ca.y), c0.w, bfhi(hl.y));
        hh[4] = fmaf(bflo(ca.z), c1.x, bflo(hl.z)); hh[5] = fmaf(bfhi(ca.z), c1.y, bfhi(hl.z)); hh[6] = fmaf(bflo(ca.w), c1.z, bflo(hl.w)); hh[7] = fmaf(bfhi(ca.w), c1.w, bfhi(hl.w));
        float s1 = 0.f, s2 = 0.f;
#pragma unroll
        for (int j = 0; j < 8; ++j) { s1 = fmaf(y[j], y[j], s1); s2 = fmaf(hh[j], hh[j], s2); }
        s1 = wave_sum(s1); s2 = wave_sum(s2);
        const float r1 = 1.0f / sqrtf(s1 * (1.0f / RW) + EPS), r2 = 1.0f / sqrtf(s2 * (1.0f / RW) + EPS);
        float g1[8], g2[8];
        g1[0] = bflo(gm.x); g1[1] = bfhi(gm.x); g1[2] = bflo(gm.y); g1[3] = bfhi(gm.y); g1[4] = bflo(gm.z); g1[5] = bfhi(gm.z); g1[6] = bflo(gm.w); g1[7] = bfhi(gm.w);
        g2[0] = bflo(gr.x); g2[1] = bfhi(gr.x); g2[2] = bflo(gr.y); g2[3] = bfhi(gr.y); g2[4] = bflo(gr.z); g2[5] = bfhi(gr.z); g2[6] = bflo(gr.w); g2[7] = bfhi(gr.w);
#pragma unroll
        for (int j = 0; j < 8; ++j) { y[j] = y[j] * r1 * siluf_(g1[j]); hh[j] = hh[j] * r2 * siluf_(g2[j]); }
        *(u32x4*)(Y + (size_t)m * DM + k0) = (u32x4){pk2(y[0], y[1]), pk2(y[2], y[3]), pk2(y[4], y[5]), pk2(y[6], y[7])};
        *(u32x4*)(Y + (size_t)m * DM + RW + k0) = (u32x4){pk2(hh[0], hh[1]), pk2(hh[2], hh[3]), pk2(hh[4], hh[5]), pk2(hh[6], hh[7])};
    }
}

__device__ __forceinline__ void phase4_simple(const Args& a, int gt, int NGT) {
    unsigned char* ws = a.ws;
    const bf16_t* Y = (const bf16_t*)(ws + WS_Y); const bf16_t* W = (const bf16_t*)(ws + WS_WOUT); const float* x = a.in[0];
    for (size_t idx = gt; idx < (size_t)T * DM; idx += NGT) {
        const int row = (int)(idx >> 10), col = (int)(idx & 1023);
        const u32x4* ap = (const u32x4*)(Y + (size_t)row * DM); const u32x4* bp = (const u32x4*)(W + (size_t)col * DM);
        float acc = 0.f;
        for (int k = 0; k < DM / 8; ++k) acc = dot8(ap[k], bp[k], acc);
        a.out[idx] = x[idx] + acc;
    }
}

__device__ __forceinline__ void phase5(const Args& a, int gw, int NGW, int lane) {
    const float* g = a.in[17];
    for (int m = gw; m < T; m += NGW) {
        f32x4* xr = (f32x4*)(a.out + (size_t)m * DM) + lane;
        f32x4 v[4]; float s = 0.f;
#pragma unroll
        for (int j = 0; j < 4; ++j) { v[j] = xr[64 * j]; s += (v[j].x * v[j].x + v[j].y * v[j].y) + (v[j].z * v[j].z + v[j].w * v[j].w); }
        s = wave_sum(s);
        const float rstd = 1.0f / sqrtf(s * (1.0f / DM) + EPS);
#pragma unroll
        for (int j = 0; j < 4; ++j) { const f32x4 gv = ((const f32x4*)g)[lane + 64 * j]; xr[64 * j] = v[j] * rstd * gv; }
    }
}

__global__ void __launch_bounds__(256, 2) mega(Args a) {
    extern __shared__ __attribute__((aligned(16))) unsigned char lds_raw[];
    LAS unsigned char* lds = (LAS unsigned char*)lds_raw;
    volatile LAS unsigned* MISC = (volatile LAS unsigned*)(lds + LDS_MISC);
    const int tid = threadIdx.x, lane = tid & 63, wave = __builtin_amdgcn_readfirstlane(tid >> 6);
    const int G = gridDim.x, NGW = G * 4, gw = blockIdx.x * 4 + wave, NGT = G * 256, gt = blockIdx.x * 256 + tid;
    if (tid < 16) MISC[tid] = 0u;
    __syncthreads();
    XcdBarrier bar; bar.bar = (unsigned*)(a.ws + WS_BAR); bar.x = 0; bar.st = nullptr;
#if MK_LAUNCHES == 1
    bar = xcd_barrier_post((unsigned*)(a.ws + WS_BAR), MISC + 8);
#define SEAM() xcd_barrier(bar)
#else
#define SEAM() do {} while (0)
#endif
    const int lo = a.ph_lo, hi = a.ph_hi;
#define IN(k) (lo <= (k) && (k) < hi)
#define BOTH(k) (IN(k) && IN((k) + 1))
    if (IN(0)) { phase0(a, lds, gw, NGW, gt, NGT, wave, lane); if (BOTH(0)) SEAM(); }
#if OPT_GEMM
    if (IN(1)) { phase1_gemm(a, lds, tid, wave, lane); if (BOTH(1)) SEAM(); }
    if (IN(2)) { phase2_gemm(a, lds, tid, wave, lane); __syncthreads(); phase2_simple(a, lds, gt, NGT, tid); if (BOTH(2)) SEAM(); }
#else
    if (IN(1)) { phase1_simple(a, gt, NGT); if (BOTH(1)) SEAM(); }
    if (IN(2)) { phase2_simple(a, lds, gt, NGT, tid); if (BOTH(2)) SEAM(); }
#endif
    if (IN(3)) { phase3_simple(a, lds, gw, NGW, gt, NGT, wave, lane); if (BOTH(3)) SEAM(); }
    if (IN(4)) { phaseY(a, gw, NGW, lane); if (BOTH(4)) SEAM(); }
#if OPT_GEMM
    if (IN(5)) { phase4_gemm(a, lds, tid, wave, lane); if (BOTH(5)) SEAM(); }
#else
    if (IN(5)) { phase4_simple(a, gt, NGT); if (BOTH(5)) SEAM(); }
#endif
    if (IN(6)) { phase5(a, gw, NGW, lane); }
}

extern "C" void kernel_launch(void* const* d_in, const int* in_sizes, int n_in, void* d_out, int out_size, void* d_ws, size_t ws_size, hipStream_t stream) {
    static int grid = 0;
    if (grid == 0) {
        if (n_in != 18 || in_sizes[0] != T * DM || out_size != T * DM || ws_size < WS_END) { fprintf(stderr, "kernel_launch: unexpected shapes (n_in %d, ws %zu)\n", n_in, ws_size); grid = -1; return; }
        int dev = 0, cus = 0, per_cu = 0;
        (void)hipGetDevice(&dev);
        (void)hipDeviceGetAttribute(&cus, hipDeviceAttributeMultiprocessorCount, dev);
        (void)hipFuncSetAttribute((const void*)mega, hipFuncAttributeMaxDynamicSharedMemorySize, LDS_BYTES);
        if (hipOccupancyMaxActiveBlocksPerMultiprocessor(&per_cu, (const void*)mega, 256, LDS_BYTES) != hipSuccess || per_cu < 1) { fprintf(stderr, "kernel_launch: occupancy query failed (%d)\n", per_cu); per_cu = 1; }
        (void)hipGetLastError();
        if (per_cu > 2) per_cu = 2;
        grid = cus * per_cu;
        fprintf(stderr, "kernel_launch: %d CUs x %d blocks\n", cus, per_cu);
    }
    if (grid < 0) return;
    Args a{};
    for (int i = 0; i < 18; ++i) a.in[i] = (const float*)d_in[i];
    a.out = (float*)d_out; a.ws = (unsigned char*)d_ws;
#if MK_LAUNCHES == 1
    (void)hipMemsetAsync((char*)d_ws + WS_BAR, 0, 16384, stream);
    a.ph_lo = 0; a.ph_hi = NPHASE;
    void* args[] = {&a};
    hipError_t e = hipLaunchCooperativeKernel((const void*)mega, dim3(grid), dim3(256), args, LDS_BYTES, stream);
    if (e != hipSuccess) fprintf(stderr, "cooperative launch failed: %s (grid %d)\n", hipGetErrorString(e), grid);
#else
    for (int p = 0; p < NPHASE; ++p) {
        a.ph_lo = p; a.ph_hi = p + 1;
        hipLaunchKernelGGL(mega, dim3(grid), dim3(256), LDS_BYTES, stream, a);
    }
#endif
}
```

```cpp
#include <hip/hip_runtime.h>
#include <cstdio>
#include <cstdint>

#ifndef MK_LAUNCHES
#define MK_LAUNCHES 1
#endif

#ifndef OPT_GEMM
#define OPT_GEMM 1
#endif

#ifndef OPT_ATTN
#define OPT_ATTN 1
#endif

#define LAS __attribute__((address_space(3)))
typedef unsigned short bf16_t;
typedef short bf16x8 __attribute__((ext_vector_type(8)));
typedef unsigned u32x4 __attribute__((ext_vector_type(4)));
typedef unsigned u32x2 __attribute__((ext_vector_type(2)));
typedef float f32x4 __attribute__((ext_vector_type(4)));

constexpr int NB = 4, S = 4096, T = NB * S, DM = 1024;
constexpr int NZ = 2048, INW = 1952;
constexpr int OQ = 0, OKV = 256, OKR = 384, OGM = 416, OXR = 928, OGR = 1440;
constexpr int NH = 8, DQK = 96, DNOPE = 64, DROPE = 32, DV = 64;
constexpr int QW = NH * DQK;
constexpr int RW = 512, CH = 64, NCH = S / CH;
constexpr float EPS = 1e-6f;
constexpr float QSCALE = 0.10206207261596575f * 1.4426950408889634f;
constexpr int NPHASE = 7;

constexpr size_t MiB = 1u << 20;
constexpr size_t WS_BAR = 0;
constexpr size_t WS_WIN = 1 * MiB;
constexpr size_t WS_WQ = 5 * MiB;
constexpr size_t WS_WKV = 5 * MiB + 512 * 1024;
constexpr size_t WS_WOUT = 6 * MiB;
constexpr size_t WS_WGA = 8 * MiB;
constexpr size_t WS_WGX = 8 * MiB + 64 * 1024;
constexpr size_t WS_ROPE = 8 * MiB + 256 * 1024;
constexpr size_t WS_RSX = 9 * MiB;
constexpr size_t WS_SP = 9 * MiB + 128 * 1024;
constexpr size_t WS_XB = 16 * MiB;
constexpr size_t WS_Y = 16 * MiB;
constexpr size_t WS_Z = 48 * MiB;
constexpr size_t WS_Q = 112 * MiB;
constexpr size_t WS_K = 136 * MiB;
constexpr size_t WS_VT = 160 * MiB;
constexpr size_t WS_YM = 176 * MiB;
constexpr size_t WS_HL = 192 * MiB;
constexpr size_t WS_CA = 208 * MiB;
constexpr size_t WS_AE = 224 * MiB;
constexpr size_t WS_HE = 225 * MiB;
constexpr size_t WS_CARRY = 226 * MiB;
constexpr size_t WS_END = 227 * MiB;

constexpr int LDS_MAIN = 68 * 1024;
constexpr int LDS_MISC = LDS_MAIN;
constexpr int LDS_BYTES = LDS_MAIN + 64;

__device__ __forceinline__ float bf2f(unsigned u16) { return __uint_as_float(u16 << 16); }
__device__ __forceinline__ float bflo(unsigned w) { return __uint_as_float(w << 16); }
__device__ __forceinline__ float bfhi(unsigned w) { return __uint_as_float(w & 0xffff0000u); }
__device__ __forceinline__ unsigned f2bf(float f) { unsigned u = __float_as_uint(f); return (u + 0x7fffu + ((u >> 16) & 1u)) >> 16; }
__device__ __forceinline__ unsigned pk2(float lo, float hi) { return f2bf(lo) | (f2bf(hi) << 16); }
__device__ __forceinline__ float wave_sum(float v) {
#pragma unroll
    for (int o = 1; o < 64; o <<= 1) v += __shfl_xor(v, o);
    return v;
}
__device__ __forceinline__ float wave_max(float v) {
#pragma unroll
    for (int o = 1; o < 64; o <<= 1) v = fmaxf(v, __shfl_xor(v, o));
    return v;
}
__device__ __forceinline__ float sigmoidf_(float v) { return 1.0f / (1.0f + __expf(-v)); }
__device__ __forceinline__ float siluf_(float v) { return v / (1.0f + __expf(-v)); }
__device__ __forceinline__ float dot8(u32x4 a, u32x4 b, float acc) {
    acc = fmaf(bflo(a.x), bflo(b.x), acc); acc = fmaf(bfhi(a.x), bfhi(b.x), acc);
    acc = fmaf(bflo(a.y), bflo(b.y), acc); acc = fmaf(bfhi(a.y), bfhi(b.y), acc);
    acc = fmaf(bflo(a.z), bflo(b.z), acc); acc = fmaf(bfhi(a.z), bfhi(b.z), acc);
    acc = fmaf(bflo(a.w), bflo(b.w), acc); acc = fmaf(bfhi(a.w), bfhi(b.w), acc);
    return acc;
}
__device__ __forceinline__ float ssq8(u32x4 a, float acc) { return dot8(a, a, acc); }
#define LDS_WAIT() asm volatile("s_waitcnt lgkmcnt(0)" ::: "memory")

#define XB_TMO      128
#define XB_XCNT(j)  (256  + 64 * (j))
#define XB_XSUB(j)  (1280 + 64 * (j))
#define XB_XGEN(j)  (2304 + 64 * (j))
#define XB_TOP      3328
#define XB_TOPGEN   3392
#define XCD_BAR_WORDS 3456
#define XB_SPIN_CAP (1u << 18)
__device__ __forceinline__ unsigned xb_ld(unsigned* p)              { return __hip_atomic_load(p, __ATOMIC_RELAXED, __HIP_MEMORY_SCOPE_AGENT); }
__device__ __forceinline__ unsigned xb_add(unsigned* p, unsigned v) { return __hip_atomic_fetch_add(p, v, __ATOMIC_RELAXED, __HIP_MEMORY_SCOPE_AGENT); }
__device__ __forceinline__ unsigned xb_xcc_id() { return (unsigned)__builtin_amdgcn_s_getreg((3 << 11) | 20) & 0xFu; }
#define XB_SPIN(cond, bar) do { unsigned _sp = 0; while (cond) { __builtin_amdgcn_s_sleep(1); \
    if ((++_sp & 255u) == 0u) { if (xb_ld(&(bar)[XB_TMO])) break; if (_sp > XB_SPIN_CAP) { atomicAdd(&(bar)[XB_TMO], 1u); break; } } } } while (0)
struct XcdBarrier { unsigned* bar; unsigned x; volatile LAS unsigned* st; };
__device__ __forceinline__ XcdBarrier xcd_barrier_post(unsigned* bar, volatile LAS unsigned* st) {
    XcdBarrier b; b.bar = bar; b.x = xb_xcc_id(); b.st = st;
    if (threadIdx.x == 0) (void)xb_add(&bar[XB_XCNT(b.x)], 1u);
    return b;
}
__device__ __forceinline__ void xcd_barrier_complete(unsigned* bar, unsigned x, unsigned& nloc, unsigned& nx) {
    const unsigned G = gridDim.x * gridDim.y * gridDim.z;
    unsigned sum, cnt, mine, sp = 0u;
    for (;;) {
        sum = 0u; cnt = 0u; mine = 0u;
#pragma unroll
        for (unsigned j = 0; j < 16; ++j) { const unsigned c = xb_ld(&bar[XB_XCNT(j)]); sum += c; cnt += (c > 0u) ? 1u : 0u; mine = (j == x) ? c : mine; }
        if (sum == G) break;
        __builtin_amdgcn_s_sleep(1);
        if ((++sp & 255u) == 0u) { if (xb_ld(&bar[XB_TMO])) break; if (sp > XB_SPIN_CAP) { atomicAdd(&bar[XB_TMO], 1u); break; } }
    }
    nloc = mine > 0u ? mine : 1u; nx = cnt > 0u ? cnt : 1u;
}
__device__ __forceinline__ void xcd_barrier(const XcdBarrier& b) {
    asm volatile("s_waitcnt vmcnt(0)" ::: "memory");
    __syncthreads();
    if (threadIdx.x == 0) {
        unsigned* bar = b.bar;
        __builtin_amdgcn_s_waitcnt(0);
        unsigned nloc = b.st[0], nx = b.st[1];
        if (nloc == 0u) { xcd_barrier_complete(bar, b.x, nloc, nx); b.st[0] = nloc; b.st[1] = nx; }
        const unsigned old = xb_add(&bar[XB_XSUB(b.x)], 1u);
        const unsigned gen = old / nloc;
        if (old + 1u == (gen + 1u) * nloc) {
            __builtin_amdgcn_fence(__ATOMIC_RELEASE, "agent");
            asm volatile("s_waitcnt vmcnt(0)" ::: "memory");
            const unsigned og = xb_add(&bar[XB_TOP], 1u);
            const unsigned tg = og / nx;
            if (og + 1u == (tg + 1u) * nx) xb_add(&bar[XB_TOPGEN], 1u);
            else XB_SPIN(xb_ld(&bar[XB_TOPGEN]) == tg, bar);
            __builtin_amdgcn_fence(__ATOMIC_ACQUIRE, "agent");
            xb_add(&bar[XB_XGEN(b.x)], 1u);
            asm volatile("s_waitcnt vmcnt(0)" ::: "memory");
        } else {
            XB_SPIN(xb_ld(&bar[XB_XGEN(b.x)]) == gen, bar);
            __builtin_amdgcn_fence(__ATOMIC_ACQUIRE, "agent");
            asm volatile("s_waitcnt vmcnt(0)" ::: "memory");
        }
    }
    __syncthreads();
}

struct Args {
    const float* in[18];
    float* out;
    unsigned char* ws;
    int ph_lo, ph_hi;
};

__device__ __forceinline__ void p0_transpose_item(const float* W, int K, int N, const float* g0, const float* g1, int ksplit,
                                                  bf16_t* WT, LAS float* scr, int item, int lane, int kvmap = 0) {
    const int nblk = N / 32, kb = item / nblk, nb = item % nblk, k0 = 64 * kb, n0 = 32 * nb;
#pragma unroll 8
    for (int i = 0; i < 32; ++i) {
        const int kk = 2 * i + (lane >> 5), k = k0 + kk;
        float gv = 1.0f;
        if (g0) gv = (k < ksplit) ? g0[k] : g1[k - ksplit];
        scr[kk * 33 + (lane & 31)] = W[(size_t)k * N + n0 + (lane & 31)] * gv;
    }
    LDS_WAIT();
    const int c = lane & 7;
#pragma unroll
    for (int j = 0; j < 4; ++j) {
        const int n = (lane >> 3) + 8 * j; const LAS float* s = scr + (8 * c) * 33 + n;
        u32x4 o; o.x = pk2(s[0 * 33], s[1 * 33]); o.y = pk2(s[2 * 33], s[3 * 33]); o.z = pk2(s[4 * 33], s[5 * 33]); o.w = pk2(s[6 * 33], s[7 * 33]);
        int nd = n0 + n;
        if (kvmap) { const int h = nd >> 7, cc = nd & 127; nd = (cc < 64) ? h * 64 + cc : 512 + h * 64 + (cc - 64); }
        *(u32x4*)(WT + (size_t)nd * K + k0 + 8 * c) = o;
    }
    LDS_WAIT();
}
__device__ __forceinline__ void rope_entry(int pos, int i, float& c, float& s) {
    const int q = i & 3, e = i >> 2;
    double f = (q == 0) ? 1.0 : (q == 1) ? 0.5623413251903491 : (q == 2) ? 0.31622776601683794 : 0.17782794100389228;
    f *= (e == 0) ? 1.0 : (e == 1) ? 0.1 : (e == 2) ? 0.01 : 0.001;
    const float inv = (float)f;
    const float ang = (float)pos * inv;
    const double x = (double)ang;
    const double n = rint(x * 0.15915494309189535);
    const double r = fma(-n, 6.283185307179586, x);
    const double r2 = r * r;
    double sv = 1.0, cv = 1.0;
#pragma unroll
    for (int k = 14; k >= 1; --k) {
        sv = 1.0 - sv * r2 * (1.0 / (double)((2 * k) * (2 * k + 1)));
        cv = 1.0 - cv * r2 * (1.0 / (double)((2 * k - 1) * (2 * k)));
    }
    s = (float)(r * sv); c = (float)cv;
}
__device__ __forceinline__ void phase0(const Args& a, LAS unsigned char* lds, int gw, int NGW, int gt, int NGT, int wave, int lane) {
    unsigned char* ws = a.ws;
    LAS float* scr = (LAS float*)(lds + wave * 8704);
    constexpr int I_IN = (DM / 64) * (INW / 32), I_Q = (256 / 64) * (QW / 32), I_KV = (128 / 64) * (1024 / 32), I_OUT = (1024 / 64) * (1024 / 32), I_G = 8 * 2;
    constexpr int NITEMS = I_IN + I_Q + I_KV + I_OUT + 2 * I_G;
    for (int it = gw; it < NITEMS; it += NGW) {
        int r = it;
        if (r < I_IN) { p0_transpose_item(a.in[2], DM, INW, a.in[1], a.in[1], DM, (bf16_t*)(ws + WS_WIN), scr, r, lane); continue; } r -= I_IN;
        if (r < I_Q) { p0_transpose_item(a.in[4], 256, QW, a.in[3], a.in[3], 256, (bf16_t*)(ws + WS_WQ), scr, r, lane); continue; } r -= I_Q;
        if (r < I_KV) { p0_transpose_item(a.in[6], 128, 1024, a.in[5], a.in[5], 128, (bf16_t*)(ws + WS_WKV), scr, r, lane, OPT_GEMM); continue; } r -= I_KV;
        if (r < I_OUT) { p0_transpose_item(a.in[16], 1024, 1024, a.in[14], a.in[15], 512, (bf16_t*)(ws + WS_WOUT), scr, r, lane); continue; } r -= I_OUT;
        if (r < I_G) { const int n = r >> 1; p0_transpose_item(a.in[9] + n * 4096, 64, 64, nullptr, nullptr, 0, (bf16_t*)(ws + WS_WGA) + n * 4096, scr, r & 1, lane); continue; } r -= I_G;
        { const int n = r >> 1; p0_transpose_item(a.in[11] + n * 4096, 64, 64, nullptr, nullptr, 0, (bf16_t*)(ws + WS_WGX) + n * 4096, scr, r & 1, lane); }
    }
    for (int i = gt; i < (NZ - INW) * DM / 8; i += NGT) ((u32x4*)(ws + WS_WIN + (size_t)INW * DM * 2))[i] = (u32x4){0u, 0u, 0u, 0u};
    for (int i = gt; i < S * 16; i += NGT) { float c, s; rope_entry(i >> 4, i & 15, c, s); ((float2*)(ws + WS_ROPE))[i] = make_float2(c, s); }
    for (int i = gt; i < RW; i += NGT) {
        const float x = __expf(-a.in[13][i]);
        const float sp = x * (1.0f - x * (0.5f - x * (1.0f / 3.0f - x * (0.25f - x * 0.2f))));
        ((float*)(ws + WS_SP))[i] = sp;
    }
    const float* x = a.in[0];
    for (int m = gw; m < T; m += NGW) {
        const f32x4* xr = (const f32x4*)(x + (size_t)m * DM) + lane;
        f32x4 v[4]; float s = 0.f;
#pragma unroll
        for (int j = 0; j < 4; ++j) { v[j] = xr[64 * j]; s += (v[j].x * v[j].x + v[j].y * v[j].y) + (v[j].z * v[j].z + v[j].w * v[j].w); }
        s = wave_sum(s);
        if (lane == 0) ((float*)(ws + WS_RSX))[m] = 1.0f / sqrtf(s * (1.0f / DM) + EPS);
        u32x2* o = (u32x2*)(ws + WS_XB + (size_t)m * DM * 2) + lane;
#pragma unroll
        for (int j = 0; j < 4; ++j) o[64 * j] = (u32x2){pk2(v[j].x, v[j].y), pk2(v[j].z, v[j].w)};
    }
}

__device__ __forceinline__ int lds_byte(int r, int c) { const int st = (r >> 4) * 2 + (c >> 5), rr = r & 15, cc = c & 31, ob = rr * 64 + cc * 2; return st * 1024 + (ob ^ (((ob >> 9) & 1) << 5)); }
__device__ __forceinline__ void stage_rc(int b, int& R, int& C) { const int st = b / 1024, sb = b % 1024, swz = sb ^ (((sb >> 9) & 1) << 5); R = (st >> 1) * 16 + swz / 64; C = (st & 1) * 32 + (swz % 64) / 2; }
__device__ __forceinline__ float ssq_frag(bf16x8 v, float acc) {
#pragma unroll
    for (int j = 0; j < 8; ++j) { const float f = __uint_as_float(((unsigned)(unsigned short)v[j]) << 16); acc = fmaf(f, f, acc); }
    return acc;
}
template <bool TRANS, bool SSQ, class Epi>
__device__ __forceinline__ void gemm_tile(LAS unsigned char* lds, const bf16_t* A, int lda, const bf16_t* B, int ldb, int nt,
                                          int tid, int wave, int lane, const Epi& epi) {
    const int wr = wave >> 1, wc = wave & 1, fr = lane & 15, fq = lane >> 4;
    unsigned voffA[4], voffB[4];
#pragma unroll
    for (int i = 0; i < 4; ++i) { int R, C; stage_rc(tid * 16 + i * 4096, R, C); voffA[i] = (unsigned)(R * lda + C) * 2u; voffB[i] = (unsigned)(R * ldb + C) * 2u; }
    const unsigned ldsw = (unsigned)wave * 1024u;
    const int aoff = lds_byte(wr * 64 + fr, fq * 8), boff = lds_byte(wc * 64 + fr, fq * 8);
#define GT_STAGE(t, b) do { _Pragma("unroll") for (int _i = 0; _i < 4; ++_i) { \
        __builtin_amdgcn_global_load_lds((const unsigned*)((const char*)A + voffA[_i] + (size_t)(t) * 128), (LAS unsigned*)(lds + (b) * 32768 + _i * 4096 + ldsw), 16, 0, 0); \
        __builtin_amdgcn_global_load_lds((const unsigned*)((const char*)B + voffB[_i] + (size_t)(t) * 128), (LAS unsigned*)(lds + (b) * 32768 + 16384 + _i * 4096 + ldsw), 16, 0, 0); } } while (0)
    f32x4 acc[4][4];
#pragma unroll
    for (int m = 0; m < 4; ++m)
#pragma unroll
        for (int n = 0; n < 4; ++n) acc[m][n] = (f32x4){0.f, 0.f, 0.f, 0.f};
    float ssq[4] = {0.f, 0.f, 0.f, 0.f};
    GT_STAGE(0, 0);
    for (int t = 0; t < nt; ++t) {
        asm volatile("s_waitcnt vmcnt(0)" ::: "memory"); __builtin_amdgcn_s_barrier(); asm volatile("" ::: "memory");
        if (t + 1 < nt) GT_STAGE(t + 1, (t + 1) & 1);
        const LAS unsigned char* bufA = lds + (t & 1) * 32768; const LAS unsigned char* bufB = bufA + 16384;
        bf16x8 af[4][2], bfr[4][2];
#pragma unroll
        for (int m = 0; m < 4; ++m)
#pragma unroll
            for (int k = 0; k < 2; ++k) af[m][k] = *(const LAS bf16x8*)(bufA + aoff + m * 2048 + k * 1024);
#pragma unroll
        for (int n = 0; n < 4; ++n)
#pragma unroll
            for (int k = 0; k < 2; ++k) bfr[n][k] = *(const LAS bf16x8*)(bufB + boff + n * 2048 + k * 1024);
        if (SSQ) {
#pragma unroll
            for (int m = 0; m < 4; ++m) { ssq[m] = ssq_frag(af[m][0], ssq[m]); ssq[m] = ssq_frag(af[m][1], ssq[m]); }
        }
#pragma unroll
        for (int k = 0; k < 2; ++k)
#pragma unroll
            for (int m = 0; m < 4; ++m)
#pragma unroll
                for (int n = 0; n < 4; ++n)
                    acc[m][n] = TRANS ? __builtin_amdgcn_mfma_f32_16x16x32_bf16(bfr[n][k], af[m][k], acc[m][n], 0, 0, 0)
                                      : __builtin_amdgcn_mfma_f32_16x16x32_bf16(af[m][k], bfr[n][k], acc[m][n], 0, 0, 0);
    }
    if (SSQ) {
#pragma unroll
        for (int m = 0; m < 4; ++m) { ssq[m] += __shfl_xor(ssq[m], 16); ssq[m] += __shfl_xor(ssq[m], 32); }
    }
    epi(acc, ssq, wr * 64, wc * 64, fr, fq);
#undef GT_STAGE
}
struct UnitOrder {
    int G, v, ntn, nunits;
    __device__ __forceinline__ void init(int G_, int bx, int ntn_, int nunits_) { G = G_; ntn = ntn_; nunits = nunits_; v = (G_ % 8 == 0) ? (bx % 8) * (G_ / 8) + bx / 8 : bx; }
    __device__ __forceinline__ bool next(int i, int& pm, int& pn) const { const int L = i * G + v; if (L >= nunits) return false; pm = L / ntn; pn = L % ntn; return true; }
};

struct EpiZ {
    bf16_t* Z; const float* RSX; int row0, col0;
    __device__ __forceinline__ void operator()(const f32x4 (&acc)[4][4], const float (&)[4], int wrow, int wcol, int fr, int fq) const {
#pragma unroll
        for (int m = 0; m < 4; ++m) {
            const int row = row0 + wrow + m * 16 + fr; const float rs = RSX[row];
#pragma unroll
            for (int n = 0; n < 4; ++n) { const f32x4 v = acc[m][n] * rs; *(u32x2*)(Z + (size_t)row * NZ + col0 + wcol + n * 16 + 4 * fq) = (u32x2){pk2(v.x, v.y), pk2(v.z, v.w)}; }
        }
    }
};
struct EpiOut {
    float* out; const float* x; int row0, col0;
    __device__ __forceinline__ void operator()(const f32x4 (&acc)[4][4], const float (&)[4], int wrow, int wcol, int fr, int fq) const {
#pragma unroll
        for (int m = 0; m < 4; ++m) {
            const int row = row0 + wrow + m * 16 + fr;
#pragma unroll
            for (int n = 0; n < 4; ++n) { const size_t o = (size_t)row * DM + col0 + wcol + n * 16 + 4 * fq; *(f32x4*)(out + o) = *(const f32x4*)(x + o) + acc[m][n]; }
        }
    }
};
struct EpiQ {
    bf16_t* Q; const float2* ROPE; int row0, col0;
    __device__ __forceinline__ void operator()(const f32x4 (&acc)[4][4], const float (&ssq)[4], int wrow, int wcol, int fr, int fq) const {
#pragma unroll
        for (int m = 0; m < 4; ++m) {
            const int row = row0 + wrow + m * 16 + fr; const float rs = QSCALE / sqrtf(ssq[m] * (1.0f / 256.0f) + EPS);
#pragma unroll
            for (int p = 0; p < 2; ++p) {
                const int c0 = col0 + wcol + p * 32;
                f32x4 v1 = acc[m][2 * p] * rs, v2 = acc[m][2 * p + 1] * rs;
                if (c0 % DQK == DNOPE) {
                    const f32x4* rp = (const f32x4*)(ROPE + (size_t)(row & (S - 1)) * 16 + 4 * fq);
                    const f32x4 r01 = rp[0], r23 = rp[1];
                    const f32x4 cs = (f32x4){r01.x, r01.z, r23.x, r23.z}, sn = (f32x4){r01.y, r01.w, r23.y, r23.w};
                    const f32x4 o1 = v1 * cs - v2 * sn, o2 = v2 * cs + v1 * sn; v1 = o1; v2 = o2;
                }
                bf16_t* qp = Q + (size_t)row * QW + c0 + 4 * fq;
                *(u32x2*)qp = (u32x2){pk2(v1.x, v1.y), pk2(v1.z, v1.w)};
                *(u32x2*)(qp + 16) = (u32x2){pk2(v2.x, v2.y), pk2(v2.z, v2.w)};
            }
        }
    }
};
struct EpiKn {
    bf16_t* K; int row0, col0;
    __device__ __forceinline__ void operator()(const f32x4 (&acc)[4][4], const float (&ssq)[4], int wrow, int wcol, int fr, int fq) const {
        const int h = (col0 + wcol) >> 6;
#pragma unroll
        for (int m = 0; m < 4; ++m) {
            const int row = row0 + wrow + m * 16 + fr; const float rs = 1.0f / sqrtf(ssq[m] * (1.0f / 128.0f) + EPS);
#pragma unroll
            for (int n = 0; n < 4; ++n) { const f32x4 v = acc[m][n] * rs; *(u32x2*)(K + (size_t)row * QW + h * DQK + n * 16 + 4 * fq) = (u32x2){pk2(v.x, v.y), pk2(v.z, v.w)}; }
        }
    }
};
struct EpiVt {
    bf16_t* VT; int row0, col0;
    __device__ __forceinline__ void operator()(const f32x4 (&acc)[4][4], const float (&ssq)[4], int wrow, int wcol, int fr, int fq) const {
        const int h = (col0 + wcol) >> 6;
#pragma unroll
        for (int m = 0; m < 4; ++m) {
            const int r0 = row0 + wrow + m * 16 + 4 * fq, b = r0 >> 12, s0 = r0 & (S - 1);
            f32x4 rs;
#pragma unroll
            for (int j = 0; j < 4; ++j) rs[j] = 1.0f / sqrtf(__shfl(ssq[m], 4 * fq + j) * (1.0f / 128.0f) + EPS);
#pragma unroll
            for (int n = 0; n < 4; ++n) { const f32x4 v = acc[m][n] * rs; *(u32x2*)(VT + ((size_t)(b * NH + h) * DV + n * 16 + fr) * S + s0) = (u32x2){pk2(v.x, v.y), pk2(v.z, v.w)}; }
        }
    }
};

__device__ __forceinline__ void phase1_gemm(const Args& a, LAS unsigned char* lds, int tid, int wave, int lane) {
    unsigned char* ws = a.ws;
    UnitOrder U; U.init(gridDim.x, blockIdx.x, NZ / 128, (T / 128) * (NZ / 128));
    int pm, pn;
    for (int i = 0; U.next(i, pm, pn); ++i) {
        EpiZ E{(bf16_t*)(ws + WS_Z), (const float*)(ws + WS_RSX), pm * 128, pn * 128};
        gemm_tile<true, false>(lds, (const bf16_t*)(ws + WS_XB) + (size_t)pm * 128 * DM, DM, (const bf16_t*)(ws + WS_WIN) + (size_t)pn * 128 * DM, DM, DM / 64, tid, wave, lane, E);
    }
}
__device__ __forceinline__ void phase4_gemm(const Args& a, LAS unsigned char* lds, int tid, int wave, int lane) {
    unsigned char* ws = a.ws;
    UnitOrder U; U.init(gridDim.x, blockIdx.x, DM / 128, (T / 128) * (DM / 128));
    int pm, pn;
    for (int i = 0; U.next(i, pm, pn); ++i) {
        EpiOut E{a.out, a.in[0], pm * 128, pn * 128};
        gemm_tile<true, false>(lds, (const bf16_t*)(ws + WS_Y) + (size_t)pm * 128 * DM, DM, (const bf16_t*)(ws + WS_WOUT) + (size_t)pn * 128 * DM, DM, DM / 64, tid, wave, lane, E);
    }
}
__device__ __forceinline__ void phase2_gemm(const Args& a, LAS unsigned char* lds, int tid, int wave, int lane) {
    unsigned char* ws = a.ws;
    const bf16_t* Z = (const bf16_t*)(ws + WS_Z);
    UnitOrder U; U.init(gridDim.x, blockIdx.x, 14, (T / 128) * 14);
    int pm, pn;
    for (int i = 0; U.next(i, pm, pn); ++i) {
        const bf16_t* Ar = Z + (size_t)pm * 128 * NZ;
        if (pn < 6) {
            EpiQ E{(bf16_t*)(ws + WS_Q), (const float2*)(ws + WS_ROPE), pm * 128, pn * 128};
            gemm_tile<true, true>(lds, Ar + OQ, NZ, (const bf16_t*)(ws + WS_WQ) + (size_t)pn * 128 * 256, 256, 4, tid, wave, lane, E);
        } else if (pn < 10) {
            EpiKn E{(bf16_t*)(ws + WS_K), pm * 128, (pn - 6) * 128};
            gemm_tile<true, true>(lds, Ar + OKV, NZ, (const bf16_t*)(ws + WS_WKV) + (size_t)(pn - 6) * 128 * 128, 128, 2, tid, wave, lane, E);
        } else {
            EpiVt E{(bf16_t*)(ws + WS_VT), pm * 128, (pn - 10) * 128};
            gemm_tile<false, true>(lds, Ar + OKV, NZ, (const bf16_t*)(ws + WS_WKV) + (size_t)(512 + (pn - 10) * 128) * 128, 128, 2, tid, wave, lane, E);
        }
    }
}

__device__ __forceinline__ void phase1_simple(const Args& a, int gt, int NGT) {
    unsigned char* ws = a.ws;
    const bf16_t* XB = (const bf16_t*)(ws + WS_XB); const bf16_t* W = (const bf16_t*)(ws + WS_WIN); const float* RSX = (const float*)(ws + WS_RSX);
    bf16_t* Z = (bf16_t*)(ws + WS_Z);
    for (size_t idx = gt; idx < (size_t)T * NZ; idx += NGT) {
        const int row = (int)(idx >> 11), col = (int)(idx & 2047);
        const u32x4* ap = (const u32x4*)(XB + (size_t)row * DM); const u32x4* bp = (const u32x4*)(W + (size_t)col * DM);
        float acc = 0.f;
        for (int k = 0; k < DM / 8; ++k) acc = dot8(ap[k], bp[k], acc);
        Z[idx] = (bf16_t)f2bf(acc * RSX[row]);
    }
}

__device__ __forceinline__ void phase2_simple(const Args& a, LAS unsigned char* lds, int gt, int NGT, int tid) {
    unsigned char* ws = a.ws;
    const bf16_t* Z = (const bf16_t*)(ws + WS_Z);
    const float2* ROPE = (const float2*)(ws + WS_ROPE);
    bf16_t* Q = (bf16_t*)(ws + WS_Q); bf16_t* K = (bf16_t*)(ws + WS_K); bf16_t* VT = (bf16_t*)(ws + WS_VT);
#if !OPT_GEMM
    {
        const bf16_t* WQ = (const bf16_t*)(ws + WS_WQ);
        for (size_t idx = gt; idx < (size_t)T * NH * 80; idx += NGT) {
            const int row = (int)(idx / (NH * 80)), rem = (int)(idx % (NH * 80)), h = rem / 80, j = rem % 80;
            const u32x4* zp = (const u32x4*)(Z + (size_t)row * NZ + OQ);
            float ss = 0.f;
            for (int k = 0; k < 32; ++k) ss = ssq8(zp[k], ss);
            const float rstd = 1.0f / sqrtf(ss * (1.0f / 256.0f) + EPS);
            if (j < 64) {
                const u32x4* wp = (const u32x4*)(WQ + (size_t)(h * DQK + j) * 256);
                float acc = 0.f;
                for (int k = 0; k < 32; ++k) acc = dot8(zp[k], wp[k], acc);
                Q[(size_t)row * QW + h * DQK + j] = (bf16_t)f2bf(acc * rstd * QSCALE);
            } else {
                const int i = j - 64;
                const u32x4* w1 = (const u32x4*)(WQ + (size_t)(h * DQK + 64 + i) * 256);
                const u32x4* w2 = (const u32x4*)(WQ + (size_t)(h * DQK + 80 + i) * 256);
                float a1 = 0.f, a2 = 0.f;
                for (int k = 0; k < 32; ++k) { a1 = dot8(zp[k], w1[k], a1); a2 = dot8(zp[k], w2[k], a2); }
                a1 *= rstd; a2 *= rstd;
                const float2 cs = ROPE[(row & (S - 1)) * 16 + i];
                Q[(size_t)row * QW + h * DQK + 64 + i] = (bf16_t)f2bf((a1 * cs.x - a2 * cs.y) * QSCALE);
                Q[(size_t)row * QW + h * DQK + 80 + i] = (bf16_t)f2bf((a2 * cs.x + a1 * cs.y) * QSCALE);
            }
        }
    }
    {
        const bf16_t* WKV = (const bf16_t*)(ws + WS_WKV);
        for (size_t idx = gt; idx < (size_t)T * 1024; idx += NGT) {
            const int row = (int)(idx >> 10), n = (int)(idx & 1023), h = n >> 7, c = n & 127;
            const u32x4* zp = (const u32x4*)(Z + (size_t)row * NZ + OKV);
            const u32x4* wp = (const u32x4*)(WKV + (size_t)n * 128);
            float ss = 0.f, acc = 0.f;
            for (int k = 0; k < 16; ++k) { ss = ssq8(zp[k], ss); acc = dot8(zp[k], wp[k], acc); }
            const float v = acc / sqrtf(ss * (1.0f / 128.0f) + EPS);
            if (c < 64) K[(size_t)row * QW + h * DQK + c] = (bf16_t)f2bf(v);
            else VT[((size_t)((row >> 12) * NH + h) * DV + (c - 64)) * S + (row & (S - 1))] = (bf16_t)f2bf(v);
        }
    }
#endif
    for (size_t idx = gt; idx < (size_t)T * 16; idx += NGT) {
        const int row = (int)(idx >> 4), i = (int)(idx & 15);
        const float z1 = bf2f(Z[(size_t)row * NZ + OKR + i]), z2 = bf2f(Z[(size_t)row * NZ + OKR + 16 + i]);
        const float2 cs = ROPE[(row & (S - 1)) * 16 + i];
        const bf16_t o1 = (bf16_t)f2bf(z1 * cs.x - z2 * cs.y), o2 = (bf16_t)f2bf(z2 * cs.x + z1 * cs.y);
#pragma unroll
        for (int h = 0; h < NH; ++h) { K[(size_t)row * QW + h * DQK + 64 + i] = o1; K[(size_t)row * QW + h * DQK + 80 + i] = o2; }
    }
    {
        LAS float* xr = (LAS float*)lds;
        LAS float* As = xr + 4096;
        LAS float* Us = As + 4096;
        const float* cw = a.in[7]; const float* cb = a.in[8];
        const float* wa = a.in[9]; const float* ba = a.in[10]; const float* wx = a.in[11]; const float* bx = a.in[12];
        const float* SP = (const float*)(ws + WS_SP);
        bf16_t* HL = (bf16_t*)(ws + WS_HL); bf16_t* CA = (bf16_t*)(ws + WS_CA);
        float* AE = (float*)(ws + WS_AE); float* HE = (float*)(ws + WS_HE);
        for (int u = blockIdx.x; u < NB * NCH * 8; u += gridDim.x) {
            const int n = u & 7, chunk = (u >> 3) & (NCH - 1), b = u >> 9;
            for (int e = tid; e < 4096; e += 256) {
                const int t = e >> 6, c = e & 63, ch = n * 64 + c, s = chunk * CH + t;
                float acc = cb[ch];
#pragma unroll
                for (int k = 0; k < 4; ++k) { const int sp = s - 3 + k; if (sp >= 0) acc = fmaf(cw[k * RW + ch], bf2f(Z[(size_t)(b * S + sp) * NZ + OXR + ch]), acc); }
                xr[e] = acc;
            }
            __syncthreads();
            {
                const int d = tid & 63, tg = tid >> 6, ch = n * 64 + d;
                const float sp = SP[ch], bav = ba[ch], bxv = bx[ch];
                for (int t = tg * 16; t < tg * 16 + 16; ++t) {
                    float pa = bav, px = bxv;
                    for (int c = 0; c < 64; ++c) { const float xv = xr[t * 64 + c]; pa = fmaf(xv, wa[(n * 64 + c) * 64 + d], pa); px = fmaf(xv, wx[(n * 64 + c) * 64 + d], px); }
                    const float r = sigmoidf_(pa), ig = sigmoidf_(px);
                    const float la = -8.0f * r * sp;
                    const float av = __expf(la);
                    float mult = sqrtf(fmaxf(1.0f - __expf(2.0f * la), 1e-12f));
                    if (chunk == 0 && t == 0) mult = 1.0f;
                    As[t * 64 + d] = av; Us[t * 64 + d] = mult * ig * xr[t * 64 + d];
                }
            }
            __syncthreads();
            if (tid < 64) {
                const int ch = n * 64 + tid;
                float hl = 0.f, ca = 1.f;
                for (int t = 0; t < 64; ++t) {
                    const float av = As[t * 64 + tid];
                    hl = fmaf(av, hl, Us[t * 64 + tid]); ca *= av;
                    const size_t o = (size_t)(b * S + chunk * CH + t) * RW + ch;
                    HL[o] = (bf16_t)f2bf(hl); CA[o] = (bf16_t)f2bf(ca);
                }
                AE[(size_t)(b * NCH + chunk) * RW + ch] = ca; HE[(size_t)(b * NCH + chunk) * RW + ch] = hl;
            }
            __syncthreads();
        }
    }
}

typedef float f32x16 __attribute__((ext_vector_type(16)));
typedef float f32x2_t __attribute__((ext_vector_type(2)));
typedef __bf16 bf16x2_t __attribute__((ext_vector_type(2)));
__device__ __forceinline__ unsigned cvtpk(float lo, float hi) { f32x2_t v = {lo, hi}; bf16x2_t b = __builtin_convertvector(v, bf16x2_t); return __builtin_bit_cast(unsigned, b); }
constexpr int AT_KROW = 208, AT_VROW = 136, AT_VOFF = 64 * AT_KROW, AT_STAGE = AT_VOFF + 64 * AT_VROW;
__device__ __forceinline__ void attn_unit(LAS unsigned char* lds, const bf16_t* Q, const bf16_t* K, const bf16_t* VT, bf16_t* YM,
                                          int b, int h, int qb, int tid, int wave, int lane) {
    const int r32 = lane & 31, hi = lane >> 5;
    const int q0 = qb * 128, NT = 2 * qb + 2, myNT = 2 * qb + 1 + (wave >> 1);
    const size_t rowbase = (size_t)b * S;
    bf16x8 qf[6];
    {
        const bf16_t* qp = Q + (rowbase + q0 + wave * 32 + r32) * QW + h * DQK + hi * 8;
#pragma unroll
        for (int ks = 0; ks < 6; ++ks) qf[ks] = *(const bf16x8*)(qp + ks * 16);
    }
    const bf16_t* gK[3]; unsigned lK[3];
#pragma unroll
    for (int i = 0; i < 3; ++i) { const int c = tid + 256 * i, key = c / 12, ch = c % 12; gK[i] = K + (rowbase + key) * QW + h * DQK + ch * 8; lK[i] = key * AT_KROW + ch * 16; }
    const bf16_t* gV[2]; unsigned lV[2];
#pragma unroll
    for (int i = 0; i < 2; ++i) { const int c = tid + 256 * i, dv = c >> 3, ch = c & 7; gV[i] = VT + ((size_t)(b * NH + h) * DV + dv) * S + ch * 8; lV[i] = AT_VOFF + dv * AT_VROW + ch * 16; }
    u32x4 kr[3], vr[2];
#define AT_LOAD(t) do { _Pragma("unroll") for (int _i = 0; _i < 3; ++_i) kr[_i] = *(const u32x4*)(gK[_i] + (size_t)(t) * 64 * QW); \
                        _Pragma("unroll") for (int _i = 0; _i < 2; ++_i) vr[_i] = *(const u32x4*)(gV[_i] + (t) * 64); } while (0)
#define AT_WRITE(s) do { LAS unsigned char* _d = lds + (s) * AT_STAGE; \
        _Pragma("unroll") for (int _i = 0; _i < 3; ++_i) *(LAS u32x4*)(_d + lK[_i]) = kr[_i]; \
        _Pragma("unroll") for (int _i = 0; _i < 2; ++_i) { *(LAS u32x2*)(_d + lV[_i]) = (u32x2){vr[_i].x, vr[_i].y}; *(LAS u32x2*)(_d + lV[_i] + 8) = (u32x2){vr[_i].z, vr[_i].w}; } } while (0)
    float m = -INFINITY, l = 0.f;
    f32x16 o0, o1;
#pragma unroll
    for (int r = 0; r < 16; ++r) { o0[r] = 0.f; o1[r] = 0.f; }
    AT_LOAD(0); AT_WRITE(0);
    __syncthreads();
    const int koff = r32 * AT_KROW + hi * 16, voff = AT_VOFF + r32 * AT_VROW + hi * 8;
    for (int t = 0; t < NT; ++t) {
        const int cur = t & 1;
        if (t + 1 < NT) AT_LOAD(t + 1);
        if (t < myNT) {
            const LAS unsigned char* kb = lds + cur * AT_STAGE + koff;
            const LAS unsigned char* vb = lds + cur * AT_STAGE + voff;
            f32x16 p0, p1;
#pragma unroll
            for (int r = 0; r < 16; ++r) { p0[r] = 0.f; p1[r] = 0.f; }
#pragma unroll
            for (int ks = 0; ks < 6; ++ks) {
                const bf16x8 a0 = *(const LAS bf16x8*)(kb + ks * 32);
                const bf16x8 a1 = *(const LAS bf16x8*)(kb + 32 * AT_KROW + ks * 32);
                p0 = __builtin_amdgcn_mfma_f32_32x32x16_bf16(a0, qf[ks], p0, 0, 0, 0);
                p1 = __builtin_amdgcn_mfma_f32_32x32x16_bf16(a1, qf[ks], p1, 0, 0, 0);
            }
            float mx = fmaxf(p0[0], p1[0]);
#pragma unroll
            for (int r = 1; r < 16; ++r) mx = fmaxf(mx, fmaxf(p0[r], p1[r]));
            mx = fmaxf(mx, __shfl_xor(mx, 32));
            const float mn = fmaxf(m, mx), alpha = __builtin_amdgcn_exp2f(m - mn);
            m = mn;
            float ls = 0.f;
#pragma unroll
            for (int r = 0; r < 16; ++r) { p0[r] = __builtin_amdgcn_exp2f(p0[r] - mn); p1[r] = __builtin_amdgcn_exp2f(p1[r] - mn); ls += p0[r] + p1[r]; }
            l = fmaf(l, alpha, ls);
#pragma unroll
            for (int r = 0; r < 16; ++r) { o0[r] *= alpha; o1[r] *= alpha; }
            u32x4 pw[4];
            pw[0] = (u32x4){cvtpk(p0[0], p0[1]), cvtpk(p0[2], p0[3]), cvtpk(p0[4], p0[5]), cvtpk(p0[6], p0[7])};
            pw[1] = (u32x4){cvtpk(p0[8], p0[9]), cvtpk(p0[10], p0[11]), cvtpk(p0[12], p0[13]), cvtpk(p0[14], p0[15])};
            pw[2] = (u32x4){cvtpk(p1[0], p1[1]), cvtpk(p1[2], p1[3]), cvtpk(p1[4], p1[5]), cvtpk(p1[6], p1[7])};
            pw[3] = (u32x4){cvtpk(p1[8], p1[9]), cvtpk(p1[10], p1[11]), cvtpk(p1[12], p1[13]), cvtpk(p1[14], p1[15])};
#pragma unroll
            for (int s = 0; s < 4; ++s) {
                const bf16x8 pf = __builtin_bit_cast(bf16x8, pw[s]);
                const u32x2 a_lo = *(const LAS u32x2*)(vb + s * 32), a_hi = *(const LAS u32x2*)(vb + s * 32 + 16);
                const u32x2 b_lo = *(const LAS u32x2*)(vb + 32 * AT_VROW + s * 32), b_hi = *(const LAS u32x2*)(vb + 32 * AT_VROW + s * 32 + 16);
                const bf16x8 v0 = __builtin_bit_cast(bf16x8, (u32x4){a_lo.x, a_lo.y, a_hi.x, a_hi.y});
                const bf16x8 v1 = __builtin_bit_cast(bf16x8, (u32x4){b_lo.x, b_lo.y, b_hi.x, b_hi.y});
                o0 = __builtin_amdgcn_mfma_f32_32x32x16_bf16(v0, pf, o0, 0, 0, 0);
                o1 = __builtin_amdgcn_mfma_f32_32x32x16_bf16(v1, pf, o1, 0, 0, 0);
            }
        }
        if (t + 1 < NT) AT_WRITE(cur ^ 1);
        __syncthreads();
    }
    l += __shfl_xor(l, 32);
    const float inv = 1.0f / l;
    bf16_t* yp = YM + (rowbase + q0 + wave * 32 + r32) * RW + h * DV + 4 * hi;
#pragma unroll
    for (int g = 0; g < 4; ++g) {
        *(u32x2*)(yp + 8 * g) = (u32x2){cvtpk(o0[4 * g] * inv, o0[4 * g + 1] * inv), cvtpk(o0[4 * g + 2] * inv, o0[4 * g + 3] * inv)};
        *(u32x2*)(yp + 32 + 8 * g) = (u32x2){cvtpk(o1[4 * g] * inv, o1[4 * g + 1] * inv), cvtpk(o1[4 * g + 2] * inv, o1[4 * g + 3] * inv)};
    }
#undef AT_LOAD
#undef AT_WRITE
}
__device__ __forceinline__ void carry_scan(const Args& a, int i) {
    unsigned char* ws = a.ws;
    const float* AE = (const float*)(ws + WS_AE); const float* HE = (const float*)(ws + WS_HE); float* CARRY = (float*)(ws + WS_CARRY);
    const int b = i >> 9, ch = i & 511; float carry = 0.f;
    for (int c0 = 0; c0 < NCH; c0 += 16) {
        float ae[16], he[16];
#pragma unroll
        for (int j = 0; j < 16; ++j) { const size_t o = (size_t)(b * NCH + c0 + j) * RW + ch; ae[j] = AE[o]; he[j] = HE[o]; }
#pragma unroll
        for (int j = 0; j < 16; ++j) { CARRY[(size_t)(b * NCH + c0 + j) * RW + ch] = carry; carry = fmaf(ae[j], carry, he[j]); }
    }
}
__device__ __forceinline__ void phase3_mfma(const Args& a, LAS unsigned char* lds, int tid, int wave, int lane) {
    unsigned char* ws = a.ws;
    const int G = gridDim.x, bx = blockIdx.x;
    const int v = (G % 8 == 0) ? (bx % 8) * (G / 8) + bx / 8 : bx;
    if (v < 8) carry_scan(a, v * 256 + tid);
    for (int p = v; p < NB * NH * 16; p += G) {
        const int bh = p >> 4, pi = p & 15;
        attn_unit(lds, (const bf16_t*)(ws + WS_Q), (const bf16_t*)(ws + WS_K), (const bf16_t*)(ws + WS_VT), (bf16_t*)(ws + WS_YM), bh >> 3, bh & 7, 31 - pi, tid, wave, lane);
        attn_unit(lds, (const bf16_t*)(ws + WS_Q), (const bf16_t*)(ws + WS_K), (const bf16_t*)(ws + WS_VT), (bf16_t*)(ws + WS_YM), bh >> 3, bh & 7, pi, tid, wave, lane);
    }
}

__device__ __forceinline__ void phase3_simple(const Args& a, LAS unsigned char* lds, int gw, int NGW, int gt, int NGT, int wave, int lane) {
    unsigned char* ws = a.ws;
    {
        const float* AE = (const float*)(ws + WS_AE); const float* HE = (const float*)(ws + WS_HE); float* CARRY = (float*)(ws + WS_CARRY);
        for (int i = gt; i < NB * RW; i += NGT) {
            const int b = i >> 9, ch = i & 511; float carry = 0.f;
            for (int c = 0; c < NCH; ++c) { const size_t o = (size_t)(b * NCH + c) * RW + ch; CARRY[o] = carry; carry = fmaf(AE[o], carry, HE[o]); }
        }
    }
    const bf16_t* Q = (const bf16_t*)(ws + WS_Q); const bf16_t* K = (const bf16_t*)(ws + WS_K); const bf16_t* VT = (const bf16_t*)(ws + WS_VT);
    bf16_t* YM = (bf16_t*)(ws + WS_YM);
    LAS float* sc = (LAS float*)(lds + wave * 16384);
    LAS float* qs = (LAS float*)(lds + 65536 + wave * 384);
    for (int item = gw; item < T * NH; item += NGW) {
        const int row = item >> 3, h = item & 7, b = row >> 12, s = row & (S - 1), nk = ((s >> 6) + 1) << 6;
        qs[lane] = bf2f(Q[(size_t)row * QW + h * DQK + lane]);
        if (lane < 32) qs[64 + lane] = bf2f(Q[(size_t)row * QW + h * DQK + 64 + lane]);
        LDS_WAIT();
        float mx = -INFINITY;
        for (int key = lane; key < nk; key += 64) {
            const u32x4* kp = (const u32x4*)(K + (size_t)(b * S + key) * QW + h * DQK);
            float dot = 0.f;
#pragma unroll
            for (int j = 0; j < 12; ++j) {
                const u32x4 v = kp[j];
                dot = fmaf(qs[8 * j + 0], bflo(v.x), dot); dot = fmaf(qs[8 * j + 1], bfhi(v.x), dot);
                dot = fmaf(qs[8 * j + 2], bflo(v.y), dot); dot = fmaf(qs[8 * j + 3], bfhi(v.y), dot);
                dot = fmaf(qs[8 * j + 4], bflo(v.z), dot); dot = fmaf(qs[8 * j + 5], bfhi(v.z), dot);
                dot = fmaf(qs[8 * j + 6], bflo(v.w), dot); dot = fmaf(qs[8 * j + 7], bfhi(v.w), dot);
            }
            sc[key] = dot; mx = fmaxf(mx, dot);
        }
        mx = wave_max(mx);
        float sum = 0.f;
        for (int key = lane; key < nk; key += 64) { const float p = __builtin_amdgcn_exp2f(sc[key] - mx); sc[key] = p; sum += p; }
        sum = wave_sum(sum);
        LDS_WAIT();
        const bf16_t* vrow = VT + ((size_t)(b * NH + h) * DV + lane) * S;
        float o = 0.f;
        for (int key = 0; key < nk; key += 8) {
            const u32x4 v = *(const u32x4*)(vrow + key);
            o = fmaf(sc[key + 0], bflo(v.x), o); o = fmaf(sc[key + 1], bfhi(v.x), o);
            o = fmaf(sc[key + 2], bflo(v.y), o); o = fmaf(sc[key + 3], bfhi(v.y), o);
            o = fmaf(sc[key + 4], bflo(v.z), o); o = fmaf(sc[key + 5], bfhi(v.z), o);
            o = fmaf(sc[key + 6], bflo(v.w), o); o = fmaf(sc[key + 7], bfhi(v.w), o);
        }
        YM[(size_t)row * RW + h * DV + lane] = (bf16_t)f2bf(o / sum);
        LDS_WAIT();
    }
}

__device__ __forceinline__ void phaseY(const Args& a, int gw, int NGW, int lane) {
    unsigned char* ws = a.ws;
    const bf16_t* Z = (const bf16_t*)(ws + WS_Z); const bf16_t* YM = (const bf16_t*)(ws + WS_YM);
    const bf16_t* HL = (const bf16_t*)(ws + WS_HL); const bf16_t* CA = (const bf16_t*)(ws + WS_CA);
    const float* CARRY = (const float*)(ws + WS_CARRY); bf16_t* Y = (bf16_t*)(ws + WS_Y);
    for (int m = gw; m < T; m += NGW) {
        const int b = m >> 12, chunk = (m & (S - 1)) >> 6, k0 = lane * 8;
        const u32x4 ym = *(const u32x4*)(YM + (size_t)m * RW + k0);
        const u32x4 hl = *(const u32x4*)(HL + (size_t)m * RW + k0);
        const u32x4 ca = *(const u32x4*)(CA + (size_t)m * RW + k0);
        const f32x4 c0 = *(const f32x4*)(CARRY + (size_t)(b * NCH + chunk) * RW + k0), c1 = *(const f32x4*)(CARRY + (size_t)(b * NCH + chunk) * RW + k0 + 4);
        const u32x4 gm = *(const u32x4*)(Z + (size_t)m * NZ + OGM + k0);
        const u32x4 gr = *(const u32x4*)(Z + (size_t)m * NZ + OGR + k0);
        float y[8], hh[8];
        y[0] = bflo(ym.x); y[1] = bfhi(ym.x); y[2] = bflo(ym.y); y[3] = bfhi(ym.y); y[4] = bflo(ym.z); y[5] = bfhi(ym.z); y[6] = bflo(ym.w); y[7] = bfhi(ym.w);
        hh[0] = fmaf(bflo(ca.x), c0.x, bflo(hl.x)); hh[1] = fmaf(bfhi(ca.x), c0.y, bfhi(hl.x)); hh[2] = fmaf(bflo(ca.y), c0.z, bflo(hl.y)); hh[3] = fmaf(bfhi(ca.y), c0.w, bfhi(hl.y));
        hh[4] = fmaf(bflo(ca.z), c1.x, bflo(hl.z)); hh[5] = fmaf(bfhi(ca.z), c1.y, bfhi(hl.z)); hh[6] = fmaf(bflo(ca.w), c1.z, bflo(hl.w)); hh[7] = fmaf(bfhi(ca.w), c1.w, bfhi(hl.w));
        float s1 = 0.f, s2 = 0.f;
#pragma unroll
        for (int j = 0; j < 8; ++j) { s1 = fmaf(y[j], y[j], s1); s2 = fmaf(hh[j], hh[j], s2); }
        s1 = wave_sum(s1); s2 = wave_sum(s2);
        const float r1 = 1.0f / sqrtf(s1 * (1.0f / RW) + EPS), r2 = 1.0f / sqrtf(s2 * (1.0f / RW) + EPS);
        float g1[8], g2[8];
        g1[0] = bflo(gm.x); g1[1] = bfhi(gm.x); g1[2] = bflo(gm.y); g1[3] = bfhi(gm.y); g1[4] = bflo(gm.z); g1[5] = bfhi(gm.z); g1[6] = bflo(gm.w); g1[7] = bfhi(gm.w);
        g2[0] = bflo(gr.x); g2[1] = bfhi(gr.x); g2[2] = bflo(gr.y); g2[3] = bfhi(gr.y); g2[4] = bflo(gr.z); g2[5] = bfhi(gr.z); g2[6] = bflo(gr.w); g2[7] = bfhi(gr.w);
#pragma unroll
        for (int j = 0; j < 8; ++j) { y[j] = y[j] * r1 * siluf_(g1[j]); hh[j] = hh[j] * r2 * siluf_(g2[j]); }
        *(u32x4*)(Y + (size_t)m * DM + k0) = (u32x4){pk2(y[0], y[1]), pk2(y[2], y[3]), pk2(y[4], y[5]), pk2(y[6], y[7])};
        *(u32x4*)(Y + (size_t)m * DM + RW + k0) = (u32x4){pk2(hh[0], hh[1]), pk2(hh[2], hh[3]), pk2(hh[4], hh[5]), pk2(hh[6], hh[7])};
    }
}

__device__ __forceinline__ void phase4_simple(const Args& a, int gt, int NGT) {
    unsigned char* ws = a.ws;
    const bf16_t* Y = (const bf16_t*)(ws + WS_Y); const bf16_t* W = (const bf16_t*)(ws + WS_WOUT); const float* x = a.in[0];
    for (size_t idx = gt; idx < (size_t)T * DM; idx += NGT) {
        const int row = (int)(idx >> 10), col = (int)(idx & 1023);
        const u32x4* ap = (const u32x4*)(Y + (size_t)row * DM); const u32x4* bp = (const u32x4*)(W + (size_t)col * DM);
        float acc = 0.f;
        for (int k = 0; k < DM / 8; ++k) acc = dot8(ap[k], bp[k], acc);
        a.out[idx] = x[idx] + acc;
    }
}

__device__ __forceinline__ void phase5(const Args& a, int gw, int NGW, int lane) {
    const float* g = a.in[17];
    for (int m = gw; m < T; m += NGW) {
        f32x4* xr = (f32x4*)(a.out + (size_t)m * DM) + lane;
        f32x4 v[4]; float s = 0.f;
#pragma unroll
        for (int j = 0; j < 4; ++j) { v[j] = xr[64 * j]; s += (v[j].x * v[j].x + v[j].y * v[j].y) + (v[j].z * v[j].z + v[j].w * v[j].w); }
        s = wave_sum(s);
        const float rstd = 1.0f / sqrtf(s * (1.0f / DM) + EPS);
#pragma unroll
        for (int j = 0; j < 4; ++j) { const f32x4 gv = ((const f32x4*)g)[lane + 64 * j]; xr[64 * j] = v[j] * rstd * gv; }
    }
}

__global__ void __launch_bounds__(256, 2) mega(Args a) {
    extern __shared__ __attribute__((aligned(16))) unsigned char lds_raw[];
    LAS unsigned char* lds = (LAS unsigned char*)lds_raw;
    volatile LAS unsigned* MISC = (volatile LAS unsigned*)(lds + LDS_MISC);
    const int tid = threadIdx.x, lane = tid & 63, wave = __builtin_amdgcn_readfirstlane(tid >> 6);
    const int G = gridDim.x, NGW = G * 4, gw = blockIdx.x * 4 + wave, NGT = G * 256, gt = blockIdx.x * 256 + tid;
    if (tid < 16) MISC[tid] = 0u;
    __syncthreads();
    XcdBarrier bar; bar.bar = (unsigned*)(a.ws + WS_BAR); bar.x = 0; bar.st = nullptr;
#if MK_LAUNCHES == 1
    bar = xcd_barrier_post((unsigned*)(a.ws + WS_BAR), MISC + 8);
#define SEAM() xcd_barrier(bar)
#else
#define SEAM() do {} while (0)
#endif
    const int lo = a.ph_lo, hi = a.ph_hi;
#define IN(k) (lo <= (k) && (k) < hi)
#define BOTH(k) (IN(k) && IN((k) + 1))
    if (IN(0)) { phase0(a, lds, gw, NGW, gt, NGT, wave, lane); if (BOTH(0)) SEAM(); }
#if OPT_GEMM
    if (IN(1)) { phase1_gemm(a, lds, tid, wave, lane); if (BOTH(1)) SEAM(); }
    if (IN(2)) { phase2_gemm(a, lds, tid, wave, lane); __syncthreads(); phase2_simple(a, lds, gt, NGT, tid); if (BOTH(2)) SEAM(); }
#else
    if (IN(1)) { phase1_simple(a, gt, NGT); if (BOTH(1)) SEAM(); }
    if (IN(2)) { phase2_simple(a, lds, gt, NGT, tid); if (BOTH(2)) SEAM(); }
#endif
#if OPT_ATTN
    if (IN(3)) { phase3_mfma(a, lds, tid, wave, lane); if (BOTH(3)) SEAM(); }
#else
    if (IN(3)) { phase3_simple(a, lds, gw, NGW, gt, NGT, wave, lane); if (BOTH(3)) SEAM(); }
#endif
    if (IN(4)) { phaseY(a, gw, NGW, lane); if (BOTH(4)) SEAM(); }
#if OPT_GEMM
    if (IN(5)) { phase4_gemm(a, lds, tid, wave, lane); if (BOTH(5)) SEAM(); }
#else
    if (IN(5)) { phase4_simple(a, gt, NGT); if (BOTH(5)) SEAM(); }
#endif
    if (IN(6)) { phase5(a, gw, NGW, lane); }
}

extern "C" void kernel_launch(void* const* d_in, const int* in_sizes, int n_in, void* d_out, int out_size, void* d_ws, size_t ws_size, hipStream_t stream) {
    static int grid = 0;
    if (grid == 0) {
        if (n_in != 18 || in_sizes[0] != T * DM || out_size != T * DM || ws_size < WS_END) { fprintf(stderr, "kernel_launch: unexpected shapes (n_in %d, ws %zu)\n", n_in, ws_size); grid = -1; return; }
        int dev = 0, cus = 0, per_cu = 0;
        (void)hipGetDevice(&dev);
        (void)hipDeviceGetAttribute(&cus, hipDeviceAttributeMultiprocessorCount, dev);
        (void)hipFuncSetAttribute((const void*)mega, hipFuncAttributeMaxDynamicSharedMemorySize, LDS_BYTES);
        if (hipOccupancyMaxActiveBlocksPerMultiprocessor(&per_cu, (const void*)mega, 256, LDS_BYTES) != hipSuccess || per_cu < 1) { fprintf(stderr, "kernel_launch: occupancy query failed (%d)\n", per_cu); per_cu = 1; }
        (void)hipGetLastError();
        if (per_cu > 2) per_cu = 2;
        grid = cus * per_cu;
        fprintf(stderr, "kernel_launch: %d CUs x %d blocks\n", cus, per_cu);
    }
    if (grid < 0) return;
    Args a{};
    for (int i = 0; i < 18; ++i) a.in[i] = (const float*)d_in[i];
    a.out = (float*)d_out; a.ws = (unsigned char*)d_ws;
#if MK_LAUNCHES == 1
    (void)hipMemsetAsync((char*)d_ws + WS_BAR, 0, 16384, stream);
    a.ph_lo = 0; a.ph_hi = NPHASE;
    void* args[] = {&a};
    hipError_t e = hipLaunchCooperativeKernel((const void*)mega, dim3(grid), dim3(256), args, LDS_BYTES, stream);
    if (e != hipSuccess) fprintf(stderr, "cooperative launch failed: %s (grid %d)\n", hipGetErrorString(e), grid);
#else
    for (int p = 0; p < NPHASE; ++p) {
        a.ph_lo = p; a.ph_hi = p + 1;
        hipLaunchKernelGGL(mega, dim3(grid), dim3(256), LDS_BYTES, stream, a);
    }
#endif
}
```

```cpp
#include <hip/hip_runtime.h>
#include <cstdio>
#include <cstdint>

#ifndef MK_LAUNCHES
#define MK_LAUNCHES 1
#endif

#ifndef OPT_GEMM
#define OPT_GEMM 1
#endif

#ifndef OPT_RNN
#define OPT_RNN 1
#endif
#ifndef OPT_ATTN
#define OPT_ATTN 1
#endif

#define LAS __attribute__((address_space(3)))
typedef unsigned short bf16_t;
typedef short bf16x8 __attribute__((ext_vector_type(8)));
typedef unsigned u32x4 __attribute__((ext_vector_type(4)));
typedef unsigned u32x2 __attribute__((ext_vector_type(2)));
typedef float f32x4 __attribute__((ext_vector_type(4)));

constexpr int NB = 4, S = 4096, T = NB * S, DM = 1024;
constexpr int NZ = 2048, INW = 1952;
constexpr int OQ = 0, OKV = 256, OKR = 384, OGM = 416, OXR = 928, OGR = 1440;
constexpr int NH = 8, DQK = 96, DNOPE = 64, DROPE = 32, DV = 64;
constexpr int QW = NH * DQK;
constexpr int RW = 512, CH = 64, NCH = S / CH;
constexpr float EPS = 1e-6f;
constexpr float QSCALE = 0.10206207261596575f * 1.4426950408889634f;
constexpr int NPHASE = 7;

constexpr size_t MiB = 1u << 20;
constexpr size_t WS_BAR = 0;
constexpr size_t WS_WIN = 1 * MiB;
constexpr size_t WS_WQ = 5 * MiB;
constexpr size_t WS_WKV = 5 * MiB + 512 * 1024;
constexpr size_t WS_WOUT = 6 * MiB;
constexpr size_t WS_WGA = 8 * MiB;
constexpr size_t WS_WGX = 8 * MiB + 64 * 1024;
constexpr size_t WS_ROPE = 8 * MiB + 256 * 1024;
constexpr size_t WS_RSX = 9 * MiB;
constexpr size_t WS_SP = 9 * MiB + 128 * 1024;
constexpr size_t WS_XB = 16 * MiB;
constexpr size_t WS_Y = 16 * MiB;
constexpr size_t WS_Z = 48 * MiB;
constexpr size_t WS_Q = 112 * MiB;
constexpr size_t WS_K = 136 * MiB;
constexpr size_t WS_VT = 160 * MiB;
constexpr size_t WS_YM = 176 * MiB;
constexpr size_t WS_HL = 192 * MiB;
constexpr size_t WS_CA = 208 * MiB;
constexpr size_t WS_AE = 224 * MiB;
constexpr size_t WS_HE = 225 * MiB;
constexpr size_t WS_CARRY = 226 * MiB;
constexpr size_t WS_END = 227 * MiB;

constexpr int LDS_MAIN = 68 * 1024;
constexpr int LDS_MISC = LDS_MAIN;
constexpr int LDS_BYTES = LDS_MAIN + 64;

__device__ __forceinline__ float bf2f(unsigned u16) { return __uint_as_float(u16 << 16); }
__device__ __forceinline__ float bflo(unsigned w) { return __uint_as_float(w << 16); }
__device__ __forceinline__ float bfhi(unsigned w) { return __uint_as_float(w & 0xffff0000u); }
__device__ __forceinline__ unsigned f2bf(float f) { unsigned u = __float_as_uint(f); return (u + 0x7fffu + ((u >> 16) & 1u)) >> 16; }
__device__ __forceinline__ unsigned pk2(float lo, float hi) { return f2bf(lo) | (f2bf(hi) << 16); }
__device__ __forceinline__ float wave_sum(float v) {
#pragma unroll
    for (int o = 1; o < 64; o <<= 1) v += __shfl_xor(v, o);
    return v;
}
__device__ __forceinline__ float wave_max(float v) {
#pragma unroll
    for (int o = 1; o < 64; o <<= 1) v = fmaxf(v, __shfl_xor(v, o));
    return v;
}
__device__ __forceinline__ float sigmoidf_(float v) { return 1.0f / (1.0f + __expf(-v)); }
__device__ __forceinline__ float siluf_(float v) { return v / (1.0f + __expf(-v)); }
__device__ __forceinline__ float dot8(u32x4 a, u32x4 b, float acc) {
    acc = fmaf(bflo(a.x), bflo(b.x), acc); acc = fmaf(bfhi(a.x), bfhi(b.x), acc);
    acc = fmaf(bflo(a.y), bflo(b.y), acc); acc = fmaf(bfhi(a.y), bfhi(b.y), acc);
    acc = fmaf(bflo(a.z), bflo(b.z), acc); acc = fmaf(bfhi(a.z), bfhi(b.z), acc);
    acc = fmaf(bflo(a.w), bflo(b.w), acc); acc = fmaf(bfhi(a.w), bfhi(b.w), acc);
    return acc;
}
__device__ __forceinline__ float ssq8(u32x4 a, float acc) { return dot8(a, a, acc); }
#define LDS_WAIT() asm volatile("s_waitcnt lgkmcnt(0)" ::: "memory")
typedef float f32x2_t __attribute__((ext_vector_type(2)));
typedef __bf16 bf16x2_t __attribute__((ext_vector_type(2)));
__device__ __forceinline__ unsigned cvtpk(float lo, float hi) { f32x2_t v = {lo, hi}; bf16x2_t b = __builtin_convertvector(v, bf16x2_t); return __builtin_bit_cast(unsigned, b); }

#define XB_TMO      128
#define XB_XCNT(j)  (256  + 64 * (j))
#define XB_XSUB(j)  (1280 + 64 * (j))
#define XB_XGEN(j)  (2304 + 64 * (j))
#define XB_TOP      3328
#define XB_TOPGEN   3392
#define XCD_BAR_WORDS 3456
#define XB_SPIN_CAP (1u << 18)
__device__ __forceinline__ unsigned xb_ld(unsigned* p)              { return __hip_atomic_load(p, __ATOMIC_RELAXED, __HIP_MEMORY_SCOPE_AGENT); }
__device__ __forceinline__ unsigned xb_add(unsigned* p, unsigned v) { return __hip_atomic_fetch_add(p, v, __ATOMIC_RELAXED, __HIP_MEMORY_SCOPE_AGENT); }
__device__ __forceinline__ unsigned xb_xcc_id() { return (unsigned)__builtin_amdgcn_s_getreg((3 << 11) | 20) & 0xFu; }
#define XB_SPIN(cond, bar) do { unsigned _sp = 0; while (cond) { __builtin_amdgcn_s_sleep(1); \
    if ((++_sp & 255u) == 0u) { if (xb_ld(&(bar)[XB_TMO])) break; if (_sp > XB_SPIN_CAP) { atomicAdd(&(bar)[XB_TMO], 1u); break; } } } } while (0)
struct XcdBarrier { unsigned* bar; unsigned x; volatile LAS unsigned* st; };
__device__ __forceinline__ XcdBarrier xcd_barrier_post(unsigned* bar, volatile LAS unsigned* st) {
    XcdBarrier b; b.bar = bar; b.x = xb_xcc_id(); b.st = st;
    if (threadIdx.x == 0) (void)xb_add(&bar[XB_XCNT(b.x)], 1u);
    return b;
}
__device__ __forceinline__ void xcd_barrier_complete(unsigned* bar, unsigned x, unsigned& nloc, unsigned& nx) {
    const unsigned G = gridDim.x * gridDim.y * gridDim.z;
    unsigned sum, cnt, mine, sp = 0u;
    for (;;) {
        sum = 0u; cnt = 0u; mine = 0u;
#pragma unroll
        for (unsigned j = 0; j < 16; ++j) { const unsigned c = xb_ld(&bar[XB_XCNT(j)]); sum += c; cnt += (c > 0u) ? 1u : 0u; mine = (j == x) ? c : mine; }
        if (sum == G) break;
        __builtin_amdgcn_s_sleep(1);
        if ((++sp & 255u) == 0u) { if (xb_ld(&bar[XB_TMO])) break; if (sp > XB_SPIN_CAP) { atomicAdd(&bar[XB_TMO], 1u); break; } }
    }
    nloc = mine > 0u ? mine : 1u; nx = cnt > 0u ? cnt : 1u;
}
__device__ __forceinline__ void xcd_barrier(const XcdBarrier& b) {
    asm volatile("s_waitcnt vmcnt(0)" ::: "memory");
    __syncthreads();
    if (threadIdx.x == 0) {
        unsigned* bar = b.bar;
        __builtin_amdgcn_s_waitcnt(0);
        unsigned nloc = b.st[0], nx = b.st[1];
        if (nloc == 0u) { xcd_barrier_complete(bar, b.x, nloc, nx); b.st[0] = nloc; b.st[1] = nx; }
        const unsigned old = xb_add(&bar[XB_XSUB(b.x)], 1u);
        const unsigned gen = old / nloc;
        if (old + 1u == (gen + 1u) * nloc) {
            __builtin_amdgcn_fence(__ATOMIC_RELEASE, "agent");
            asm volatile("s_waitcnt vmcnt(0)" ::: "memory");
            const unsigned og = xb_add(&bar[XB_TOP], 1u);
            const unsigned tg = og / nx;
            if (og + 1u == (tg + 1u) * nx) xb_add(&bar[XB_TOPGEN], 1u);
            else XB_SPIN(xb_ld(&bar[XB_TOPGEN]) == tg, bar);
            __builtin_amdgcn_fence(__ATOMIC_ACQUIRE, "agent");
            xb_add(&bar[XB_XGEN(b.x)], 1u);
            asm volatile("s_waitcnt vmcnt(0)" ::: "memory");
        } else {
            XB_SPIN(xb_ld(&bar[XB_XGEN(b.x)]) == gen, bar);
            __builtin_amdgcn_fence(__ATOMIC_ACQUIRE, "agent");
            asm volatile("s_waitcnt vmcnt(0)" ::: "memory");
        }
    }
    __syncthreads();
}

struct Args {
    const float* in[18];
    float* out;
    unsigned char* ws;
    int ph_lo, ph_hi;
};

__device__ __forceinline__ void p0_transpose_item(const float* W, int K, int N, const float* g0, const float* g1, int ksplit,
                                                  bf16_t* WT, LAS float* scr, int item, int lane, int kvmap = 0) {
    const int nblk = N / 32, kb = item / nblk, nb = item % nblk, k0 = 64 * kb, n0 = 32 * nb;
#pragma unroll 8
    for (int i = 0; i < 32; ++i) {
        const int kk = 2 * i + (lane >> 5), k = k0 + kk;
        float gv = 1.0f;
        if (g0) gv = (k < ksplit) ? g0[k] : g1[k - ksplit];
        scr[kk * 33 + (lane & 31)] = W[(size_t)k * N + n0 + (lane & 31)] * gv;
    }
    LDS_WAIT();
    const int c = lane & 7;
#pragma unroll
    for (int j = 0; j < 4; ++j) {
        const int n = (lane >> 3) + 8 * j; const LAS float* s = scr + (8 * c) * 33 + n;
        u32x4 o; o.x = pk2(s[0 * 33], s[1 * 33]); o.y = pk2(s[2 * 33], s[3 * 33]); o.z = pk2(s[4 * 33], s[5 * 33]); o.w = pk2(s[6 * 33], s[7 * 33]);
        int nd = n0 + n;
        if (kvmap) { const int h = nd >> 7, cc = nd & 127; nd = (cc < 64) ? h * 64 + cc : 512 + h * 64 + (cc - 64); }
        *(u32x4*)(WT + (size_t)nd * K + k0 + 8 * c) = o;
    }
    LDS_WAIT();
}
__device__ __forceinline__ void rope_entry(int pos, int i, float& c, float& s) {
    const int q = i & 3, e = i >> 2;
    double f = (q == 0) ? 1.0 : (q == 1) ? 0.5623413251903491 : (q == 2) ? 0.31622776601683794 : 0.17782794100389228;
    f *= (e == 0) ? 1.0 : (e == 1) ? 0.1 : (e == 2) ? 0.01 : 0.001;
    const float inv = (float)f;
    const float ang = (float)pos * inv;
    const double x = (double)ang;
    const double n = rint(x * 0.15915494309189535);
    const double r = fma(-n, 6.283185307179586, x);
    const double r2 = r * r;
    double sv = 1.0, cv = 1.0;
#pragma unroll
    for (int k = 14; k >= 1; --k) {
        sv = 1.0 - sv * r2 * (1.0 / (double)((2 * k) * (2 * k + 1)));
        cv = 1.0 - cv * r2 * (1.0 / (double)((2 * k - 1) * (2 * k)));
    }
    s = (float)(r * sv); c = (float)cv;
}
__device__ __forceinline__ void phase0(const Args& a, LAS unsigned char* lds, int gw, int NGW, int gt, int NGT, int wave, int lane) {
    unsigned char* ws = a.ws;
    LAS float* scr = (LAS float*)(lds + wave * 8704);
    constexpr int I_IN = (DM / 64) * (INW / 32), I_Q = (256 / 64) * (QW / 32), I_KV = (128 / 64) * (1024 / 32), I_OUT = (1024 / 64) * (1024 / 32), I_G = 8 * 2;
    constexpr int NITEMS = I_IN + I_Q + I_KV + I_OUT + 2 * I_G;
    for (int it = gw; it < NITEMS; it += NGW) {
        int r = it;
        if (r < I_IN) { p0_transpose_item(a.in[2], DM, INW, a.in[1], a.in[1], DM, (bf16_t*)(ws + WS_WIN), scr, r, lane); continue; } r -= I_IN;
        if (r < I_Q) { p0_transpose_item(a.in[4], 256, QW, a.in[3], a.in[3], 256, (bf16_t*)(ws + WS_WQ), scr, r, lane); continue; } r -= I_Q;
        if (r < I_KV) { p0_transpose_item(a.in[6], 128, 1024, a.in[5], a.in[5], 128, (bf16_t*)(ws + WS_WKV), scr, r, lane, OPT_GEMM); continue; } r -= I_KV;
        if (r < I_OUT) { p0_transpose_item(a.in[16], 1024, 1024, a.in[14], a.in[15], 512, (bf16_t*)(ws + WS_WOUT), scr, r, lane); continue; } r -= I_OUT;
        if (r < I_G) { const int n = r >> 1; p0_transpose_item(a.in[9] + n * 4096, 64, 64, nullptr, nullptr, 0, (bf16_t*)(ws + WS_WGA) + n * 4096, scr, r & 1, lane); continue; } r -= I_G;
        { const int n = r >> 1; p0_transpose_item(a.in[11] + n * 4096, 64, 64, nullptr, nullptr, 0, (bf16_t*)(ws + WS_WGX) + n * 4096, scr, r & 1, lane); }
    }
    for (int i = gt; i < (NZ - INW) * DM / 8; i += NGT) ((u32x4*)(ws + WS_WIN + (size_t)INW * DM * 2))[i] = (u32x4){0u, 0u, 0u, 0u};
    for (int i = gt; i < S * 16; i += NGT) { float c, s; rope_entry(i >> 4, i & 15, c, s); ((float2*)(ws + WS_ROPE))[i] = make_float2(c, s); }
    for (int i = gt; i < RW; i += NGT) {
        const float x = __expf(-a.in[13][i]);
        const float sp = x * (1.0f - x * (0.5f - x * (1.0f / 3.0f - x * (0.25f - x * 0.2f))));
        ((float*)(ws + WS_SP))[i] = sp;
    }
    const float* x = a.in[0];
    for (int m = gw; m < T; m += NGW) {
        const f32x4* xr = (const f32x4*)(x + (size_t)m * DM) + lane;
        f32x4 v[4]; float s = 0.f;
#pragma unroll
        for (int j = 0; j < 4; ++j) { v[j] = xr[64 * j]; s += (v[j].x * v[j].x + v[j].y * v[j].y) + (v[j].z * v[j].z + v[j].w * v[j].w); }
        s = wave_sum(s);
        if (lane == 0) ((float*)(ws + WS_RSX))[m] = 1.0f / sqrtf(s * (1.0f / DM) + EPS);
        u32x2* o = (u32x2*)(ws + WS_XB + (size_t)m * DM * 2) + lane;
#pragma unroll
        for (int j = 0; j < 4; ++j) o[64 * j] = (u32x2){pk2(v[j].x, v[j].y), pk2(v[j].z, v[j].w)};
    }
}

__device__ __forceinline__ int lds_byte(int r, int c) { const int st = (r >> 4) * 2 + (c >> 5), rr = r & 15, cc = c & 31, ob = rr * 64 + cc * 2; return st * 1024 + (ob ^ (((ob >> 9) & 1) << 5)); }
__device__ __forceinline__ void stage_rc(int b, int& R, int& C) { const int st = b / 1024, sb = b % 1024, swz = sb ^ (((sb >> 9) & 1) << 5); R = (st >> 1) * 16 + swz / 64; C = (st & 1) * 32 + (swz % 64) / 2; }
__device__ __forceinline__ float ssq_frag(bf16x8 v, float acc) {
#pragma unroll
    for (int j = 0; j < 8; ++j) { const float f = __uint_as_float(((unsigned)(unsigned short)v[j]) << 16); acc = fmaf(f, f, acc); }
    return acc;
}
template <bool TRANS, bool SSQ, class Epi>
__device__ __forceinline__ void gemm_tile(LAS unsigned char* lds, const bf16_t* A, int lda, const bf16_t* B, int ldb, int nt,
                                          int tid, int wave, int lane, const Epi& epi) {
    const int wr = wave >> 1, wc = wave & 1, fr = lane & 15, fq = lane >> 4;
    unsigned voffA[4], voffB[4];
#pragma unroll
    for (int i = 0; i < 4; ++i) { int R, C; stage_rc(tid * 16 + i * 4096, R, C); voffA[i] = (unsigned)(R * lda + C) * 2u; voffB[i] = (unsigned)(R * ldb + C) * 2u; }
    const unsigned ldsw = (unsigned)wave * 1024u;
    const int aoff = lds_byte(wr * 64 + fr, fq * 8), boff = lds_byte(wc * 64 + fr, fq * 8);
#define GT_STAGE(t, b) do { _Pragma("unroll") for (int _i = 0; _i < 4; ++_i) { \
        __builtin_amdgcn_global_load_lds((const unsigned*)((const char*)A + voffA[_i] + (size_t)(t) * 128), (LAS unsigned*)(lds + (b) * 32768 + _i * 4096 + ldsw), 16, 0, 0); \
        __builtin_amdgcn_global_load_lds((const unsigned*)((const char*)B + voffB[_i] + (size_t)(t) * 128), (LAS unsigned*)(lds + (b) * 32768 + 16384 + _i * 4096 + ldsw), 16, 0, 0); } } while (0)
    f32x4 acc[4][4];
#pragma unroll
    for (int m = 0; m < 4; ++m)
#pragma unroll
        for (int n = 0; n < 4; ++n) acc[m][n] = (f32x4){0.f, 0.f, 0.f, 0.f};
    float ssq[4] = {0.f, 0.f, 0.f, 0.f};
    GT_STAGE(0, 0);
    for (int t = 0; t < nt; ++t) {
        asm volatile("s_waitcnt vmcnt(0)" ::: "memory"); __builtin_amdgcn_s_barrier(); asm volatile("" ::: "memory");
        if (t + 1 < nt) GT_STAGE(t + 1, (t + 1) & 1);
        const LAS unsigned char* bufA = lds + (t & 1) * 32768; const LAS unsigned char* bufB = bufA + 16384;
        bf16x8 af[4][2], bfr[4][2];
#pragma unroll
        for (int m = 0; m < 4; ++m)
#pragma unroll
            for (int k = 0; k < 2; ++k) af[m][k] = *(const LAS bf16x8*)(bufA + aoff + m * 2048 + k * 1024);
#pragma unroll
        for (int n = 0; n < 4; ++n)
#pragma unroll
            for (int k = 0; k < 2; ++k) bfr[n][k] = *(const LAS bf16x8*)(bufB + boff + n * 2048 + k * 1024);
        if (SSQ) {
#pragma unroll
            for (int m = 0; m < 4; ++m) { ssq[m] = ssq_frag(af[m][0], ssq[m]); ssq[m] = ssq_frag(af[m][1], ssq[m]); }
        }
#pragma unroll
        for (int k = 0; k < 2; ++k)
#pragma unroll
            for (int m = 0; m < 4; ++m)
#pragma unroll
                for (int n = 0; n < 4; ++n)
                    acc[m][n] = TRANS ? __builtin_amdgcn_mfma_f32_16x16x32_bf16(bfr[n][k], af[m][k], acc[m][n], 0, 0, 0)
                                      : __builtin_amdgcn_mfma_f32_16x16x32_bf16(af[m][k], bfr[n][k], acc[m][n], 0, 0, 0);
    }
    if (SSQ) {
#pragma unroll
        for (int m = 0; m < 4; ++m) { ssq[m] += __shfl_xor(ssq[m], 16); ssq[m] += __shfl_xor(ssq[m], 32); }
    }
    epi(acc, ssq, wr * 64, wc * 64, fr, fq);
#undef GT_STAGE
}
struct UnitOrder {
    int G, v, ntn, nunits;
    __device__ __forceinline__ void init(int G_, int bx, int ntn_, int nunits_) { G = G_; ntn = ntn_; nunits = nunits_; v = (G_ % 8 == 0) ? (bx % 8) * (G_ / 8) + bx / 8 : bx; }
    __device__ __forceinline__ bool next(int i, int& pm, int& pn) const { const int L = i * G + v; if (L >= nunits) return false; pm = L / ntn; pn = L % ntn; return true; }
};

struct EpiZ {
    bf16_t* Z; const float* RSX; int row0, col0;
    __device__ __forceinline__ void operator()(const f32x4 (&acc)[4][4], const float (&)[4], int wrow, int wcol, int fr, int fq) const {
#pragma unroll
        for (int m = 0; m < 4; ++m) {
            const int row = row0 + wrow + m * 16 + fr; const float rs = RSX[row];
#pragma unroll
            for (int n = 0; n < 4; ++n) { const f32x4 v = acc[m][n] * rs; *(u32x2*)(Z + (size_t)row * NZ + col0 + wcol + n * 16 + 4 * fq) = (u32x2){pk2(v.x, v.y), pk2(v.z, v.w)}; }
        }
    }
};
struct EpiOut {
    float* out; const float* x; int row0, col0;
    __device__ __forceinline__ void operator()(const f32x4 (&acc)[4][4], const float (&)[4], int wrow, int wcol, int fr, int fq) const {
#pragma unroll
        for (int m = 0; m < 4; ++m) {
            const int row = row0 + wrow + m * 16 + fr;
#pragma unroll
            for (int n = 0; n < 4; ++n) { const size_t o = (size_t)row * DM + col0 + wcol + n * 16 + 4 * fq; *(f32x4*)(out + o) = *(const f32x4*)(x + o) + acc[m][n]; }
        }
    }
};
struct EpiQ {
    bf16_t* Q; const float2* ROPE; int row0, col0;
    __device__ __forceinline__ void operator()(const f32x4 (&acc)[4][4], const float (&ssq)[4], int wrow, int wcol, int fr, int fq) const {
#pragma unroll
        for (int m = 0; m < 4; ++m) {
            const int row = row0 + wrow + m * 16 + fr; const float rs = QSCALE / sqrtf(ssq[m] * (1.0f / 256.0f) + EPS);
#pragma unroll
            for (int p = 0; p < 2; ++p) {
                const int c0 = col0 + wcol + p * 32;
                f32x4 v1 = acc[m][2 * p] * rs, v2 = acc[m][2 * p + 1] * rs;
                if (c0 % DQK == DNOPE) {
                    const f32x4* rp = (const f32x4*)(ROPE + (size_t)(row & (S - 1)) * 16 + 4 * fq);
                    const f32x4 r01 = rp[0], r23 = rp[1];
                    const f32x4 cs = (f32x4){r01.x, r01.z, r23.x, r23.z}, sn = (f32x4){r01.y, r01.w, r23.y, r23.w};
                    const f32x4 o1 = v1 * cs - v2 * sn, o2 = v2 * cs + v1 * sn; v1 = o1; v2 = o2;
                }
                bf16_t* qp = Q + (size_t)row * QW + c0 + 4 * fq;
                *(u32x2*)qp = (u32x2){pk2(v1.x, v1.y), pk2(v1.z, v1.w)};
                *(u32x2*)(qp + 16) = (u32x2){pk2(v2.x, v2.y), pk2(v2.z, v2.w)};
            }
        }
    }
};
struct EpiKn {
    bf16_t* K; int row0, col0;
    __device__ __forceinline__ void operator()(const f32x4 (&acc)[4][4], const float (&ssq)[4], int wrow, int wcol, int fr, int fq) const {
        const int h = (col0 + wcol) >> 6;
#pragma unroll
        for (int m = 0; m < 4; ++m) {
            const int row = row0 + wrow + m * 16 + fr; const float rs = 1.0f / sqrtf(ssq[m] * (1.0f / 128.0f) + EPS);
#pragma unroll
            for (int n = 0; n < 4; ++n) { const f32x4 v = acc[m][n] * rs; *(u32x2*)(K + (size_t)row * QW + h * DQK + n * 16 + 4 * fq) = (u32x2){pk2(v.x, v.y), pk2(v.z, v.w)}; }
        }
    }
};
struct EpiVt {
    bf16_t* VT; int row0, col0;
    __device__ __forceinline__ void operator()(const f32x4 (&acc)[4][4], const float (&ssq)[4], int wrow, int wcol, int fr, int fq) const {
        const int h = (col0 + wcol) >> 6;
#pragma unroll
        for (int m = 0; m < 4; ++m) {
            const int r0 = row0 + wrow + m * 16 + 4 * fq, b = r0 >> 12, s0 = r0 & (S - 1);
            f32x4 rs;
#pragma unroll
            for (int j = 0; j < 4; ++j) rs[j] = 1.0f / sqrtf(__shfl(ssq[m], 4 * fq + j) * (1.0f / 128.0f) + EPS);
#pragma unroll
            for (int n = 0; n < 4; ++n) { const f32x4 v = acc[m][n] * rs; *(u32x2*)(VT + ((size_t)(b * NH + h) * DV + n * 16 + fr) * S + s0) = (u32x2){pk2(v.x, v.y), pk2(v.z, v.w)}; }
        }
    }
};

__device__ __forceinline__ void phase1_gemm(const Args& a, LAS unsigned char* lds, int tid, int wave, int lane) {
    unsigned char* ws = a.ws;
    UnitOrder U; U.init(gridDim.x, blockIdx.x, NZ / 128, (T / 128) * (NZ / 128));
    int pm, pn;
    for (int i = 0; U.next(i, pm, pn); ++i) {
        EpiZ E{(bf16_t*)(ws + WS_Z), (const float*)(ws + WS_RSX), pm * 128, pn * 128};
        gemm_tile<true, false>(lds, (const bf16_t*)(ws + WS_XB) + (size_t)pm * 128 * DM, DM, (const bf16_t*)(ws + WS_WIN) + (size_t)pn * 128 * DM, DM, DM / 64, tid, wave, lane, E);
    }
}
__device__ __forceinline__ void phase4_gemm(const Args& a, LAS unsigned char* lds, int tid, int wave, int lane) {
    unsigned char* ws = a.ws;
    UnitOrder U; U.init(gridDim.x, blockIdx.x, DM / 128, (T / 128) * (DM / 128));
    int pm, pn;
    for (int i = 0; U.next(i, pm, pn); ++i) {
        EpiOut E{a.out, a.in[0], pm * 128, pn * 128};
        gemm_tile<true, false>(lds, (const bf16_t*)(ws + WS_Y) + (size_t)pm * 128 * DM, DM, (const bf16_t*)(ws + WS_WOUT) + (size_t)pn * 128 * DM, DM, DM / 64, tid, wave, lane, E);
    }
}
__device__ __forceinline__ void phase2_gemm(const Args& a, LAS unsigned char* lds, int tid, int wave, int lane) {
    unsigned char* ws = a.ws;
    const bf16_t* Z = (const bf16_t*)(ws + WS_Z);
    UnitOrder U; U.init(gridDim.x, blockIdx.x, 14, (T / 128) * 14);
    int pm, pn;
    for (int i = 0; U.next(i, pm, pn); ++i) {
        const bf16_t* Ar = Z + (size_t)pm * 128 * NZ;
        if (pn < 6) {
            EpiQ E{(bf16_t*)(ws + WS_Q), (const float2*)(ws + WS_ROPE), pm * 128, pn * 128};
            gemm_tile<true, true>(lds, Ar + OQ, NZ, (const bf16_t*)(ws + WS_WQ) + (size_t)pn * 128 * 256, 256, 4, tid, wave, lane, E);
        } else if (pn < 10) {
            EpiKn E{(bf16_t*)(ws + WS_K), pm * 128, (pn - 6) * 128};
            gemm_tile<true, true>(lds, Ar + OKV, NZ, (const bf16_t*)(ws + WS_WKV) + (size_t)(pn - 6) * 128 * 128, 128, 2, tid, wave, lane, E);
        } else {
            EpiVt E{(bf16_t*)(ws + WS_VT), pm * 128, (pn - 10) * 128};
            gemm_tile<false, true>(lds, Ar + OKV, NZ, (const bf16_t*)(ws + WS_WKV) + (size_t)(512 + (pn - 10) * 128) * 128, 128, 2, tid, wave, lane, E);
        }
    }
}

__device__ __forceinline__ void k_pe_items(const Args& a, int gt, int NGT) {
    unsigned char* ws = a.ws;
    const bf16_t* Z = (const bf16_t*)(ws + WS_Z); const float2* ROPE = (const float2*)(ws + WS_ROPE); bf16_t* K = (bf16_t*)(ws + WS_K);
    for (size_t idx = gt; idx < (size_t)T * 16; idx += NGT) {
        const int row = (int)(idx >> 4), i = (int)(idx & 15);
        const float z1 = bf2f(Z[(size_t)row * NZ + OKR + i]), z2 = bf2f(Z[(size_t)row * NZ + OKR + 16 + i]);
        const float2 cs = ROPE[(row & (S - 1)) * 16 + i];
        const bf16_t o1 = (bf16_t)f2bf(z1 * cs.x - z2 * cs.y), o2 = (bf16_t)f2bf(z2 * cs.x + z1 * cs.y);
#pragma unroll
        for (int h = 0; h < NH; ++h) { K[(size_t)row * QW + h * DQK + 64 + i] = o1; K[(size_t)row * QW + h * DQK + 80 + i] = o2; }
    }
}
constexpr int RN_XB = 0, RN_XBROW = 144, RN_XF = 64 * RN_XBROW, RN_SEG = RN_XF + 64 * 64 * 4;
__device__ __forceinline__ void rnn_units(const Args& a, LAS unsigned char* lds, int tid, int wave, int lane) {
    unsigned char* ws = a.ws;
    const bf16_t* Z = (const bf16_t*)(ws + WS_Z);
    bf16_t* HL = (bf16_t*)(ws + WS_HL); bf16_t* CA = (bf16_t*)(ws + WS_CA);
    float* AE = (float*)(ws + WS_AE); float* HE = (float*)(ws + WS_HE);
    const int fr = lane & 15, fq = lane >> 4, c8 = tid & 7, tt = tid >> 3;
    LAS float* xf = (LAS float*)(lds + RN_XF); LAS float* seg = (LAS float*)(lds + RN_SEG);
    int nload = -1;
    bf16x8 wfa[4][2], wfx[4][2];
    float spv[4], bav[4], bxv[4];
    for (int u = blockIdx.x; u < NB * NCH * 8; u += gridDim.x) {
        const int n = u & 7, chunk = (u >> 3) & (NCH - 1), b = u >> 9;
        if (n != nload) {
            nload = n;
            const bf16_t* WA = (const bf16_t*)(ws + WS_WGA) + n * 4096; const bf16_t* WX = (const bf16_t*)(ws + WS_WGX) + n * 4096;
#pragma unroll
            for (int nt = 0; nt < 4; ++nt) {
#pragma unroll
                for (int k = 0; k < 2; ++k) { wfa[nt][k] = *(const bf16x8*)(WA + (16 * nt + fr) * 64 + 32 * k + 8 * fq); wfx[nt][k] = *(const bf16x8*)(WX + (16 * nt + fr) * 64 + 32 * k + 8 * fq); }
                const int ch = n * 64 + 16 * nt + fr;
                spv[nt] = ((const float*)(ws + WS_SP))[ch]; bav[nt] = a.in[10][ch]; bxv[nt] = a.in[12][ch];
            }
        }
        {
            const int s0 = chunk * CH + 2 * tt, ch0 = n * 64 + 8 * c8;
            f32x4 cwv[4][2], cbv[2];
#pragma unroll
            for (int k = 0; k < 4; ++k) { cwv[k][0] = *(const f32x4*)(a.in[7] + k * RW + ch0); cwv[k][1] = *(const f32x4*)(a.in[7] + k * RW + ch0 + 4); }
            cbv[0] = *(const f32x4*)(a.in[8] + ch0); cbv[1] = *(const f32x4*)(a.in[8] + ch0 + 4);
            f32x4 xv[5][2];
#pragma unroll
            for (int k = 0; k < 5; ++k) {
                const int sp = s0 - 3 + k;
                u32x4 raw = (u32x4){0u, 0u, 0u, 0u};
                if (sp >= 0) raw = *(const u32x4*)(Z + (size_t)(b * S + sp) * NZ + OXR + n * 64 + 8 * c8);
                xv[k][0] = (f32x4){bflo(raw.x), bfhi(raw.x), bflo(raw.y), bfhi(raw.y)}; xv[k][1] = (f32x4){bflo(raw.z), bfhi(raw.z), bflo(raw.w), bfhi(raw.w)};
            }
#pragma unroll
            for (int e = 0; e < 2; ++e) {
                f32x4 y0 = cbv[0], y1 = cbv[1];
#pragma unroll
                for (int k = 0; k < 4; ++k) { y0 += cwv[k][0] * xv[k + e][0]; y1 += cwv[k][1] * xv[k + e][1]; }
                const int t = 2 * tt + e;
                *(LAS f32x4*)(xf + t * 64 + 8 * c8) = y0; *(LAS f32x4*)(xf + t * 64 + 8 * c8 + 4) = y1;
                *(LAS u32x4*)(lds + RN_XB + t * RN_XBROW + 16 * c8) = (u32x4){cvtpk(y0.x, y0.y), cvtpk(y0.z, y0.w), cvtpk(y1.x, y1.y), cvtpk(y1.z, y1.w)};
            }
        }
        __syncthreads();
        f32x4 ga[4], gx[4];
        {
            const bf16x8 af0 = *(const LAS bf16x8*)(lds + RN_XB + (16 * wave + fr) * RN_XBROW + 16 * fq);
            const bf16x8 af1 = *(const LAS bf16x8*)(lds + RN_XB + (16 * wave + fr) * RN_XBROW + 64 + 16 * fq);
#pragma unroll
            for (int nt = 0; nt < 4; ++nt) {
                f32x4 z = (f32x4){0.f, 0.f, 0.f, 0.f};
                ga[nt] = __builtin_amdgcn_mfma_f32_16x16x32_bf16(af0, wfa[nt][0], z, 0, 0, 0);
                ga[nt] = __builtin_amdgcn_mfma_f32_16x16x32_bf16(af1, wfa[nt][1], ga[nt], 0, 0, 0);
                gx[nt] = __builtin_amdgcn_mfma_f32_16x16x32_bf16(af0, wfx[nt][0], z, 0, 0, 0);
                gx[nt] = __builtin_amdgcn_mfma_f32_16x16x32_bf16(af1, wfx[nt][1], gx[nt], 0, 0, 0);
            }
        }
        f32x4 hl[4], ca[4];
#pragma unroll
        for (int nt = 0; nt < 4; ++nt) {
            float hrun = 0.f, arun = 1.f;
#pragma unroll
            for (int j = 0; j < 4; ++j) {
                const int t = 16 * wave + 4 * fq + j;
                const float r = sigmoidf_(ga[nt][j] + bav[nt]), ig = sigmoidf_(gx[nt][j] + bxv[nt]);
                const float av = __expf(-8.0f * r * spv[nt]);
                float mult = sqrtf(fmaxf(1.0f - av * av, 1e-12f));
                if (chunk == 0 && t == 0) mult = 1.0f;
                const float uu = mult * ig * xf[t * 64 + 16 * nt + fr];
                hrun = fmaf(av, hrun, uu); arun *= av;
                hl[nt][j] = hrun; ca[nt][j] = arun;
            }
            float A = arun, H = hrun;
            { const float Ap = __shfl_up(A, 16), Hp = __shfl_up(H, 16); if (fq >= 1) { H = fmaf(A, Hp, H); A *= Ap; } }
            { const float Ap = __shfl_up(A, 32), Hp = __shfl_up(H, 32); if (fq >= 2) { H = fmaf(A, Hp, H); A *= Ap; } }
            float Ae = __shfl_up(A, 16), He = __shfl_up(H, 16);
            if (fq == 0) { Ae = 1.f; He = 0.f; }
#pragma unroll
            for (int j = 0; j < 4; ++j) { hl[nt][j] = fmaf(ca[nt][j], He, hl[nt][j]); ca[nt][j] *= Ae; }
            if (fq == 3) { seg[wave * 64 + 16 * nt + fr] = A; seg[256 + wave * 64 + 16 * nt + fr] = H; }
        }
        __syncthreads();
#pragma unroll
        for (int nt = 0; nt < 4; ++nt) {
            float Aw = 1.f, Hw = 0.f;
            for (int w2 = 0; w2 < wave; ++w2) { const float A2 = seg[w2 * 64 + 16 * nt + fr], H2 = seg[256 + w2 * 64 + 16 * nt + fr]; Hw = fmaf(A2, Hw, H2); Aw *= A2; }
            const int ch = n * 64 + 16 * nt + fr;
#pragma unroll
            for (int j = 0; j < 4; ++j) {
                const float hv = fmaf(ca[nt][j], Hw, hl[nt][j]), cv = ca[nt][j] * Aw;
                const size_t o = (size_t)(b * S + chunk * CH + 16 * wave + 4 * fq + j) * RW + ch;
                HL[o] = (bf16_t)(cvtpk(hv, 0.f) & 0xffffu); CA[o] = (bf16_t)(cvtpk(cv, 0.f) & 0xffffu);
                if (j == 3 && fq == 3 && wave == 3) { AE[(size_t)(b * NCH + chunk) * RW + ch] = cv; HE[(size_t)(b * NCH + chunk) * RW + ch] = hv; }
            }
        }
    }
}

__device__ __forceinline__ void phase1_simple(const Args& a, int gt, int NGT) {
    unsigned char* ws = a.ws;
    const bf16_t* XB = (const bf16_t*)(ws + WS_XB); const bf16_t* W = (const bf16_t*)(ws + WS_WIN); const float* RSX = (const float*)(ws + WS_RSX);
    bf16_t* Z = (bf16_t*)(ws + WS_Z);
    for (size_t idx = gt; idx < (size_t)T * NZ; idx += NGT) {
        const int row = (int)(idx >> 11), col = (int)(idx & 2047);
        const u32x4* ap = (const u32x4*)(XB + (size_t)row * DM); const u32x4* bp = (const u32x4*)(W + (size_t)col * DM);
        float acc = 0.f;
        for (int k = 0; k < DM / 8; ++k) acc = dot8(ap[k], bp[k], acc);
        Z[idx] = (bf16_t)f2bf(acc * RSX[row]);
    }
}

__device__ __forceinline__ void phase2_simple(const Args& a, LAS unsigned char* lds, int gt, int NGT, int tid) {
    unsigned char* ws = a.ws;
    const bf16_t* Z = (const bf16_t*)(ws + WS_Z);
    const float2* ROPE = (const float2*)(ws + WS_ROPE);
    bf16_t* Q = (bf16_t*)(ws + WS_Q); bf16_t* K = (bf16_t*)(ws + WS_K); bf16_t* VT = (bf16_t*)(ws + WS_VT);
#if !OPT_GEMM
    {
        const bf16_t* WQ = (const bf16_t*)(ws + WS_WQ);
        for (size_t idx = gt; idx < (size_t)T * NH * 80; idx += NGT) {
            const int row = (int)(idx / (NH * 80)), rem = (int)(idx % (NH * 80)), h = rem / 80, j = rem % 80;
            const u32x4* zp = (const u32x4*)(Z + (size_t)row * NZ + OQ);
            float ss = 0.f;
            for (int k = 0; k < 32; ++k) ss = ssq8(zp[k], ss);
            const float rstd = 1.0f / sqrtf(ss * (1.0f / 256.0f) + EPS);
            if (j < 64) {
                const u32x4* wp = (const u32x4*)(WQ + (size_t)(h * DQK + j) * 256);
                float acc = 0.f;
                for (int k = 0; k < 32; ++k) acc = dot8(zp[k], wp[k], acc);
                Q[(size_t)row * QW + h * DQK + j] = (bf16_t)f2bf(acc * rstd * QSCALE);
            } else {
                const int i = j - 64;
                const u32x4* w1 = (const u32x4*)(WQ + (size_t)(h * DQK + 64 + i) * 256);
                const u32x4* w2 = (const u32x4*)(WQ + (size_t)(h * DQK + 80 + i) * 256);
                float a1 = 0.f, a2 = 0.f;
                for (int k = 0; k < 32; ++k) { a1 = dot8(zp[k], w1[k], a1); a2 = dot8(zp[k], w2[k], a2); }
                a1 *= rstd; a2 *= rstd;
                const float2 cs = ROPE[(row & (S - 1)) * 16 + i];
                Q[(size_t)row * QW + h * DQK + 64 + i] = (bf16_t)f2bf((a1 * cs.x - a2 * cs.y) * QSCALE);
                Q[(size_t)row * QW + h * DQK + 80 + i] = (bf16_t)f2bf((a2 * cs.x + a1 * cs.y) * QSCALE);
            }
        }
    }
    {
        const bf16_t* WKV = (const bf16_t*)(ws + WS_WKV);
        for (size_t idx = gt; idx < (size_t)T * 1024; idx += NGT) {
            const int row = (int)(idx >> 10), n = (int)(idx & 1023), h = n >> 7, c = n & 127;
            const u32x4* zp = (const u32x4*)(Z + (size_t)row * NZ + OKV);
            const u32x4* wp = (const u32x4*)(WKV + (size_t)n * 128);
            float ss = 0.f, acc = 0.f;
            for (int k = 0; k < 16; ++k) { ss = ssq8(zp[k], ss); acc = dot8(zp[k], wp[k], acc); }
            const float v = acc / sqrtf(ss * (1.0f / 128.0f) + EPS);
            if (c < 64) K[(size_t)row * QW + h * DQK + c] = (bf16_t)f2bf(v);
            else VT[((size_t)((row >> 12) * NH + h) * DV + (c - 64)) * S + (row & (S - 1))] = (bf16_t)f2bf(v);
        }
    }
#endif
    for (size_t idx = gt; idx < (size_t)T * 16; idx += NGT) {
        const int row = (int)(idx >> 4), i = (int)(idx & 15);
        const float z1 = bf2f(Z[(size_t)row * NZ + OKR + i]), z2 = bf2f(Z[(size_t)row * NZ + OKR + 16 + i]);
        const float2 cs = ROPE[(row & (S - 1)) * 16 + i];
        const bf16_t o1 = (bf16_t)f2bf(z1 * cs.x - z2 * cs.y), o2 = (bf16_t)f2bf(z2 * cs.x + z1 * cs.y);
#pragma unroll
        for (int h = 0; h < NH; ++h) { K[(size_t)row * QW + h * DQK + 64 + i] = o1; K[(size_t)row * QW + h * DQK + 80 + i] = o2; }
    }
    {
        LAS float* xr = (LAS float*)lds;
        LAS float* As = xr + 4096;
        LAS float* Us = As + 4096;
        const float* cw = a.in[7]; const float* cb = a.in[8];
        const float* wa = a.in[9]; const float* ba = a.in[10]; const float* wx = a.in[11]; const float* bx = a.in[12];
        const float* SP = (const float*)(ws + WS_SP);
        bf16_t* HL = (bf16_t*)(ws + WS_HL); bf16_t* CA = (bf16_t*)(ws + WS_CA);
        float* AE = (float*)(ws + WS_AE); float* HE = (float*)(ws + WS_HE);
        for (int u = blockIdx.x; u < NB * NCH * 8; u += gridDim.x) {
            const int n = u & 7, chunk = (u >> 3) & (NCH - 1), b = u >> 9;
            for (int e = tid; e < 4096; e += 256) {
                const int t = e >> 6, c = e & 63, ch = n * 64 + c, s = chunk * CH + t;
                float acc = cb[ch];
#pragma unroll
                for (int k = 0; k < 4; ++k) { const int sp = s - 3 + k; if (sp >= 0) acc = fmaf(cw[k * RW + ch], bf2f(Z[(size_t)(b * S + sp) * NZ + OXR + ch]), acc); }
                xr[e] = acc;
            }
            __syncthreads();
            {
                const int d = tid & 63, tg = tid >> 6, ch = n * 64 + d;
                const float sp = SP[ch], bav = ba[ch], bxv = bx[ch];
                for (int t = tg * 16; t < tg * 16 + 16; ++t) {
                    float pa = bav, px = bxv;
                    for (int c = 0; c < 64; ++c) { const float xv = xr[t * 64 + c]; pa = fmaf(xv, wa[(n * 64 + c) * 64 + d], pa); px = fmaf(xv, wx[(n * 64 + c) * 64 + d], px); }
                    const float r = sigmoidf_(pa), ig = sigmoidf_(px);
                    const float la = -8.0f * r * sp;
                    const float av = __expf(la);
                    float mult = sqrtf(fmaxf(1.0f - __expf(2.0f * la), 1e-12f));
                    if (chunk == 0 && t == 0) mult = 1.0f;
                    As[t * 64 + d] = av; Us[t * 64 + d] = mult * ig * xr[t * 64 + d];
                }
            }
            __syncthreads();
            if (tid < 64) {
                const int ch = n * 64 + tid;
                float hl = 0.f, ca = 1.f;
                for (int t = 0; t < 64; ++t) {
                    const float av = As[t * 64 + tid];
                    hl = fmaf(av, hl, Us[t * 64 + tid]); ca *= av;
                    const size_t o = (size_t)(b * S + chunk * CH + t) * RW + ch;
                    HL[o] = (bf16_t)f2bf(hl); CA[o] = (bf16_t)f2bf(ca);
                }
                AE[(size_t)(b * NCH + chunk) * RW + ch] = ca; HE[(size_t)(b * NCH + chunk) * RW + ch] = hl;
            }
            __syncthreads();
        }
    }
}

typedef float f32x16 __attribute__((ext_vector_type(16)));
constexpr int AT_KROW = 208, AT_VROW = 136, AT_VOFF = 64 * AT_KROW, AT_STAGE = AT_VOFF + 64 * AT_VROW;
__device__ __forceinline__ void attn_unit(LAS unsigned char* lds, const bf16_t* Q, const bf16_t* K, const bf16_t* VT, bf16_t* YM,
                                          int b, int h, int qb, int tid, int wave, int lane) {
    const int r32 = lane & 31, hi = lane >> 5;
    const int q0 = qb * 128, NT = 2 * qb + 2, myNT = 2 * qb + 1 + (wave >> 1);
    const size_t rowbase = (size_t)b * S;
    bf16x8 qf[6];
    {
        const bf16_t* qp = Q + (rowbase + q0 + wave * 32 + r32) * QW + h * DQK + hi * 8;
#pragma unroll
        for (int ks = 0; ks < 6; ++ks) qf[ks] = *(const bf16x8*)(qp + ks * 16);
    }
    const bf16_t* gK[3]; unsigned lK[3];
#pragma unroll
    for (int i = 0; i < 3; ++i) { const int c = tid + 256 * i, key = c / 12, ch = c % 12; gK[i] = K + (rowbase + key) * QW + h * DQK + ch * 8; lK[i] = key * AT_KROW + ch * 16; }
    const bf16_t* gV[2]; unsigned lV[2];
#pragma unroll
    for (int i = 0; i < 2; ++i) { const int c = tid + 256 * i, dv = c >> 3, ch = c & 7; gV[i] = VT + ((size_t)(b * NH + h) * DV + dv) * S + ch * 8; lV[i] = AT_VOFF + dv * AT_VROW + ch * 16; }
    u32x4 kr[3], vr[2];
#define AT_LOAD(t) do { _Pragma("unroll") for (int _i = 0; _i < 3; ++_i) kr[_i] = *(const u32x4*)(gK[_i] + (size_t)(t) * 64 * QW); \
                        _Pragma("unroll") for (int _i = 0; _i < 2; ++_i) vr[_i] = *(const u32x4*)(gV[_i] + (t) * 64); } while (0)
#define AT_WRITE(s) do { LAS unsigned char* _d = lds + (s) * AT_STAGE; \
        _Pragma("unroll") for (int _i = 0; _i < 3; ++_i) *(LAS u32x4*)(_d + lK[_i]) = kr[_i]; \
        _Pragma("unroll") for (int _i = 0; _i < 2; ++_i) { *(LAS u32x2*)(_d + lV[_i]) = (u32x2){vr[_i].x, vr[_i].y}; *(LAS u32x2*)(_d + lV[_i] + 8) = (u32x2){vr[_i].z, vr[_i].w}; } } while (0)
    float m = -INFINITY, l = 0.f;
    f32x16 o0, o1;
#pragma unroll
    for (int r = 0; r < 16; ++r) { o0[r] = 0.f; o1[r] = 0.f; }
    AT_LOAD(0); AT_WRITE(0);
    __syncthreads();
    const int koff = r32 * AT_KROW + hi * 16, voff = AT_VOFF + r32 * AT_VROW + hi * 8;
    for (int t = 0; t < NT; ++t) {
        const int cur = t & 1;
        if (t + 1 < NT) AT_LOAD(t + 1);
        if (t < myNT) {
            const LAS unsigned char* kb = lds + cur * AT_STAGE + koff;
            const LAS unsigned char* vb = lds + cur * AT_STAGE + voff;
            f32x16 p0, p1;
#pragma unroll
            for (int r = 0; r < 16; ++r) { p0[r] = 0.f; p1[r] = 0.f; }
#pragma unroll
            for (int ks = 0; ks < 6; ++ks) {
                const bf16x8 a0 = *(const LAS bf16x8*)(kb + ks * 32);
                const bf16x8 a1 = *(const LAS bf16x8*)(kb + 32 * AT_KROW + ks * 32);
                p0 = __builtin_amdgcn_mfma_f32_32x32x16_bf16(a0, qf[ks], p0, 0, 0, 0);
                p1 = __builtin_amdgcn_mfma_f32_32x32x16_bf16(a1, qf[ks], p1, 0, 0, 0);
            }
            float mx = fmaxf(p0[0], p1[0]);
#pragma unroll
            for (int r = 1; r < 16; ++r) mx = fmaxf(mx, fmaxf(p0[r], p1[r]));
            mx = fmaxf(mx, __shfl_xor(mx, 32));
            const float mn = fmaxf(m, mx), alpha = __builtin_amdgcn_exp2f(m - mn);
            m = mn;
            float ls = 0.f;
#pragma unroll
            for (int r = 0; r < 16; ++r) { p0[r] = __builtin_amdgcn_exp2f(p0[r] - mn); p1[r] = __builtin_amdgcn_exp2f(p1[r] - mn); ls += p0[r] + p1[r]; }
            l = fmaf(l, alpha, ls);
#pragma unroll
            for (int r = 0; r < 16; ++r) { o0[r] *= alpha; o1[r] *= alpha; }
            u32x4 pw[4];
            pw[0] = (u32x4){cvtpk(p0[0], p0[1]), cvtpk(p0[2], p0[3]), cvtpk(p0[4], p0[5]), cvtpk(p0[6], p0[7])};
            pw[1] = (u32x4){cvtpk(p0[8], p0[9]), cvtpk(p0[10], p0[11]), cvtpk(p0[12], p0[13]), cvtpk(p0[14], p0[15])};
            pw[2] = (u32x4){cvtpk(p1[0], p1[1]), cvtpk(p1[2], p1[3]), cvtpk(p1[4], p1[5]), cvtpk(p1[6], p1[7])};
            pw[3] = (u32x4){cvtpk(p1[8], p1[9]), cvtpk(p1[10], p1[11]), cvtpk(p1[12], p1[13]), cvtpk(p1[14], p1[15])};
#pragma unroll
            for (int s = 0; s < 4; ++s) {
                const bf16x8 pf = __builtin_bit_cast(bf16x8, pw[s]);
                const u32x2 a_lo = *(const LAS u32x2*)(vb + s * 32), a_hi = *(const LAS u32x2*)(vb + s * 32 + 16);
                const u32x2 b_lo = *(const LAS u32x2*)(vb + 32 * AT_VROW + s * 32), b_hi = *(const LAS u32x2*)(vb + 32 * AT_VROW + s * 32 + 16);
                const bf16x8 v0 = __builtin_bit_cast(bf16x8, (u32x4){a_lo.x, a_lo.y, a_hi.x, a_hi.y});
                const bf16x8 v1 = __builtin_bit_cast(bf16x8, (u32x4){b_lo.x, b_lo.y, b_hi.x, b_hi.y});
                o0 = __builtin_amdgcn_mfma_f32_32x32x16_bf16(v0, pf, o0, 0, 0, 0);
                o1 = __builtin_amdgcn_mfma_f32_32x32x16_bf16(v1, pf, o1, 0, 0, 0);
            }
        }
        if (t + 1 < NT) AT_WRITE(cur ^ 1);
        __syncthreads();
    }
    l += __shfl_xor(l, 32);
    const float inv = 1.0f / l;
    bf16_t* yp = YM + (rowbase + q0 + wave * 32 + r32) * RW + h * DV + 4 * hi;
#pragma unroll
    for (int g = 0; g < 4; ++g) {
        *(u32x2*)(yp + 8 * g) = (u32x2){cvtpk(o0[4 * g] * inv, o0[4 * g + 1] * inv), cvtpk(o0[4 * g + 2] * inv, o0[4 * g + 3] * inv)};
        *(u32x2*)(yp + 32 + 8 * g) = (u32x2){cvtpk(o1[4 * g] * inv, o1[4 * g + 1] * inv), cvtpk(o1[4 * g + 2] * inv, o1[4 * g + 3] * inv)};
    }
#undef AT_LOAD
#undef AT_WRITE
}
__device__ __forceinline__ void carry_scan(const Args& a, int i) {
    unsigned char* ws = a.ws;
    const float* AE = (const float*)(ws + WS_AE); const float* HE = (const float*)(ws + WS_HE); float* CARRY = (float*)(ws + WS_CARRY);
    const int b = i >> 9, ch = i & 511; float carry = 0.f;
    for (int c0 = 0; c0 < NCH; c0 += 16) {
        float ae[16], he[16];
#pragma unroll
        for (int j = 0; j < 16; ++j) { const size_t o = (size_t)(b * NCH + c0 + j) * RW + ch; ae[j] = AE[o]; he[j] = HE[o]; }
#pragma unroll
        for (int j = 0; j < 16; ++j) { CARRY[(size_t)(b * NCH + c0 + j) * RW + ch] = carry; carry = fmaf(ae[j], carry, he[j]); }
    }
}
__device__ __forceinline__ void phase3_mfma(const Args& a, LAS unsigned char* lds, int tid, int wave, int lane) {
    unsigned char* ws = a.ws;
    const int G = gridDim.x, bx = blockIdx.x;
    const int v = (G % 8 == 0) ? (bx % 8) * (G / 8) + bx / 8 : bx;
    if (v < 8) carry_scan(a, v * 256 + tid);
    for (int p = v; p < NB * NH * 16; p += G) {
        const int bh = p >> 4, pi = p & 15;
        attn_unit(lds, (const bf16_t*)(ws + WS_Q), (const bf16_t*)(ws + WS_K), (const bf16_t*)(ws + WS_VT), (bf16_t*)(ws + WS_YM), bh >> 3, bh & 7, 31 - pi, tid, wave, lane);
        attn_unit(lds, (const bf16_t*)(ws + WS_Q), (const bf16_t*)(ws + WS_K), (const bf16_t*)(ws + WS_VT), (bf16_t*)(ws + WS_YM), bh >> 3, bh & 7, pi, tid, wave, lane);
    }
}

__device__ __forceinline__ void phase3_simple(const Args& a, LAS unsigned char* lds, int gw, int NGW, int gt, int NGT, int wave, int lane) {
    unsigned char* ws = a.ws;
    {
        const float* AE = (const float*)(ws + WS_AE); const float* HE = (const float*)(ws + WS_HE); float* CARRY = (float*)(ws + WS_CARRY);
        for (int i = gt; i < NB * RW; i += NGT) {
            const int b = i >> 9, ch = i & 511; float carry = 0.f;
            for (int c = 0; c < NCH; ++c) { const size_t o = (size_t)(b * NCH + c) * RW + ch; CARRY[o] = carry; carry = fmaf(AE[o], carry, HE[o]); }
        }
    }
    const bf16_t* Q = (const bf16_t*)(ws + WS_Q); const bf16_t* K = (const bf16_t*)(ws + WS_K); const bf16_t* VT = (const bf16_t*)(ws + WS_VT);
    bf16_t* YM = (bf16_t*)(ws + WS_YM);
    LAS float* sc = (LAS float*)(lds + wave * 16384);
    LAS float* qs = (LAS float*)(lds + 65536 + wave * 384);
    for (int item = gw; item < T * NH; item += NGW) {
        const int row = item >> 3, h = item & 7, b = row >> 12, s = row & (S - 1), nk = ((s >> 6) + 1) << 6;
        qs[lane] = bf2f(Q[(size_t)row * QW + h * DQK + lane]);
        if (lane < 32) qs[64 + lane] = bf2f(Q[(size_t)row * QW + h * DQK + 64 + lane]);
        LDS_WAIT();
        float mx = -INFINITY;
        for (int key = lane; key < nk; key += 64) {
            const u32x4* kp = (const u32x4*)(K + (size_t)(b * S + key) * QW + h * DQK);
            float dot = 0.f;
#pragma unroll
            for (int j = 0; j < 12; ++j) {
                const u32x4 v = kp[j];
                dot = fmaf(qs[8 * j + 0], bflo(v.x), dot); dot = fmaf(qs[8 * j + 1], bfhi(v.x), dot);
                dot = fmaf(qs[8 * j + 2], bflo(v.y), dot); dot = fmaf(qs[8 * j + 3], bfhi(v.y), dot);
                dot = fmaf(qs[8 * j + 4], bflo(v.z), dot); dot = fmaf(qs[8 * j + 5], bfhi(v.z), dot);
                dot = fmaf(qs[8 * j + 6], bflo(v.w), dot); dot = fmaf(qs[8 * j + 7], bfhi(v.w), dot);
            }
            sc[key] = dot; mx = fmaxf(mx, dot);
        }
        mx = wave_max(mx);
        float sum = 0.f;
        for (int key = lane; key < nk; key += 64) { const float p = __builtin_amdgcn_exp2f(sc[key] - mx); sc[key] = p; sum += p; }
        sum = wave_sum(sum);
        LDS_WAIT();
        const bf16_t* vrow = VT + ((size_t)(b * NH + h) * DV + lane) * S;
        float o = 0.f;
        for (int key = 0; key < nk; key += 8) {
            const u32x4 v = *(const u32x4*)(vrow + key);
            o = fmaf(sc[key + 0], bflo(v.x), o); o = fmaf(sc[key + 1], bfhi(v.x), o);
            o = fmaf(sc[key + 2], bflo(v.y), o); o = fmaf(sc[key + 3], bfhi(v.y), o);
            o = fmaf(sc[key + 4], bflo(v.z), o); o = fmaf(sc[key + 5], bfhi(v.z), o);
            o = fmaf(sc[key + 6], bflo(v.w), o); o = fmaf(sc[key + 7], bfhi(v.w), o);
        }
        YM[(size_t)row * RW + h * DV + lane] = (bf16_t)f2bf(o / sum);
        LDS_WAIT();
    }
}

__device__ __forceinline__ void phaseY(const Args& a, int gw, int NGW, int lane) {
    unsigned char* ws = a.ws;
    const bf16_t* Z = (const bf16_t*)(ws + WS_Z); const bf16_t* YM = (const bf16_t*)(ws + WS_YM);
    const bf16_t* HL = (const bf16_t*)(ws + WS_HL); const bf16_t* CA = (const bf16_t*)(ws + WS_CA);
    const float* CARRY = (const float*)(ws + WS_CARRY); bf16_t* Y = (bf16_t*)(ws + WS_Y);
    for (int m = gw; m < T; m += NGW) {
        const int b = m >> 12, chunk = (m & (S - 1)) >> 6, k0 = lane * 8;
        const u32x4 ym = *(const u32x4*)(YM + (size_t)m * RW + k0);
        const u32x4 hl = *(const u32x4*)(HL + (size_t)m * RW + k0);
        const u32x4 ca = *(const u32x4*)(CA + (size_t)m * RW + k0);
        const f32x4 c0 = *(const f32x4*)(CARRY + (size_t)(b * NCH + chunk) * RW + k0), c1 = *(const f32x4*)(CARRY + (size_t)(b * NCH + chunk) * RW + k0 + 4);
        const u32x4 gm = *(const u32x4*)(Z + (size_t)m * NZ + OGM + k0);
        const u32x4 gr = *(const u32x4*)(Z + (size_t)m * NZ + OGR + k0);
        float y[8], hh[8];
        y[0] = bflo(ym.x); y[1] = bfhi(ym.x); y[2] = bflo(ym.y); y[3] = bfhi(ym.y); y[4] = bflo(ym.z); y[5] = bfhi(ym.z); y[6] = bflo(ym.w); y[7] = bfhi(ym.w);
        hh[0] = fmaf(bflo(ca.x), c0.x, bflo(hl.x)); hh[1] = fmaf(bfhi(ca.x), c0.y, bfhi(hl.x)); hh[2] = fmaf(bflo(ca.y), c0.z, bflo(hl.y)); hh[3] = fmaf(bfhi(ca.y), c0.w, bfhi(hl.y));
        hh[4] = fmaf(bflo(ca.z), c1.x, bflo(hl.z)); hh[5] = fmaf(bfhi(ca.z), c1.y, bfhi(hl.z)); hh[6] = fmaf(bflo(ca.w), c1.z, bflo(hl.w)); hh[7] = fmaf(bfhi(ca.w), c1.w, bfhi(hl.w));
        float s1 = 0.f, s2 = 0.f;
#pragma unroll
        for (int j = 0; j < 8; ++j) { s1 = fmaf(y[j], y[j], s1); s2 = fmaf(hh[j], hh[j], s2); }
        s1 = wave_sum(s1); s2 = wave_sum(s2);
        const float r1 = 1.0f / sqrtf(s1 * (1.0f / RW) + EPS), r2 = 1.0f / sqrtf(s2 * (1.0f / RW) + EPS);
        float g1[8], g2[8];
        g1[0] = bflo(gm.x); g1[1] = bfhi(gm.x); g1[2] = bflo(gm.y); g1[3] = bfhi(gm.y); g1[4] = bflo(gm.z); g1[5] = bfhi(gm.z); g1[6] = bflo(gm.w); g1[7] = bfhi(gm.w);
        g2[0] = bflo(gr.x); g2[1] = bfhi(gr.x); g2[2] = bflo(gr.y); g2[3] = bfhi(gr.y); g2[4] = bflo(gr.z); g2[5] = bfhi(gr.z); g2[6] = bflo(gr.w); g2[7] = bfhi(gr.w);
#pragma unroll
        for (int j = 0; j < 8; ++j) { y[j] = y[j] * r1 * siluf_(g1[j]); hh[j] = hh[j] * r2 * siluf_(g2[j]); }
        *(u32x4*)(Y + (size_t)m * DM + k0) = (u32x4){pk2(y[0], y[1]), pk2(y[2], y[3]), pk2(y[4], y[5]), pk2(y[6], y[7])};
        *(u32x4*)(Y + (size_t)m * DM + RW + k0) = (u32x4){pk2(hh[0], hh[1]), pk2(hh[2], hh[3]), pk2(hh[4], hh[5]), pk2(hh[6], hh[7])};
    }
}

__device__ __forceinline__ void phase4_simple(const Args& a, int gt, int NGT) {
    unsigned char* ws = a.ws;
    const bf16_t* Y = (const bf16_t*)(ws + WS_Y); const bf16_t* W = (const bf16_t*)(ws + WS_WOUT); const float* x = a.in[0];
    for (size_t idx = gt; idx < (size_t)T * DM; idx += NGT) {
        const int row = (int)(idx >> 10), col = (int)(idx & 1023);
        const u32x4* ap = (const u32x4*)(Y + (size_t)row * DM); const u32x4* bp = (const u32x4*)(W + (size_t)col * DM);
        float acc = 0.f;
        for (int k = 0; k < DM / 8; ++k) acc = dot8(ap[k], bp[k], acc);
        a.out[idx] = x[idx] + acc;
    }
}

__device__ __forceinline__ void phase5(const Args& a, int gw, int NGW, int lane) {
    const float* g = a.in[17];
    for (int m = gw; m < T; m += NGW) {
        f32x4* xr = (f32x4*)(a.out + (size_t)m * DM) + lane;
        f32x4 v[4]; float s = 0.f;
#pragma unroll
        for (int j = 0; j < 4; ++j) { v[j] = xr[64 * j]; s += (v[j].x * v[j].x + v[j].y * v[j].y) + (v[j].z * v[j].z + v[j].w * v[j].w); }
        s = wave_sum(s);
        const float rstd = 1.0f / sqrtf(s * (1.0f / DM) + EPS);
#pragma unroll
        for (int j = 0; j < 4; ++j) { const f32x4 gv = ((const f32x4*)g)[lane + 64 * j]; xr[64 * j] = v[j] * rstd * gv; }
    }
}

__global__ void __launch_bounds__(256, 2) mega(Args a) {
    extern __shared__ __attribute__((aligned(16))) unsigned char lds_raw[];
    LAS unsigned char* lds = (LAS unsigned char*)lds_raw;
    volatile LAS unsigned* MISC = (volatile LAS unsigned*)(lds + LDS_MISC);
    const int tid = threadIdx.x, lane = tid & 63, wave = __builtin_amdgcn_readfirstlane(tid >> 6);
    const int G = gridDim.x, NGW = G * 4, gw = blockIdx.x * 4 + wave, NGT = G * 256, gt = blockIdx.x * 256 + tid;
    if (tid < 16) MISC[tid] = 0u;
    __syncthreads();
    XcdBarrier bar; bar.bar = (unsigned*)(a.ws + WS_BAR); bar.x = 0; bar.st = nullptr;
#if MK_LAUNCHES == 1
    bar = xcd_barrier_post((unsigned*)(a.ws + WS_BAR), MISC + 8);
#define SEAM() xcd_barrier(bar)
#else
#define SEAM() do {} while (0)
#endif
    const int lo = a.ph_lo, hi = a.ph_hi;
#define IN(k) (lo <= (k) && (k) < hi)
#define BOTH(k) (IN(k) && IN((k) + 1))
    if (IN(0)) { phase0(a, lds, gw, NGW, gt, NGT, wave, lane); if (BOTH(0)) SEAM(); }
#if OPT_GEMM
    if (IN(1)) { phase1_gemm(a, lds, tid, wave, lane); if (BOTH(1)) SEAM(); }
#if OPT_RNN
    if (IN(2)) { phase2_gemm(a, lds, tid, wave, lane); __syncthreads(); k_pe_items(a, gt, NGT); rnn_units(a, lds, tid, wave, lane); if (BOTH(2)) SEAM(); }
#else
    if (IN(2)) { phase2_gemm(a, lds, tid, wave, lane); __syncthreads(); phase2_simple(a, lds, gt, NGT, tid); if (BOTH(2)) SEAM(); }
#endif
#else
    if (IN(1)) { phase1_simple(a, gt, NGT); if (BOTH(1)) SEAM(); }
    if (IN(2)) { phase2_simple(a, lds, gt, NGT, tid); if (BOTH(2)) SEAM(); }
#endif
#if OPT_ATTN
    if (IN(3)) { phase3_mfma(a, lds, tid, wave, lane); if (BOTH(3)) SEAM(); }
#else
    if (IN(3)) { phase3_simple(a, lds, gw, NGW, gt, NGT, wave, lane); if (BOTH(3)) SEAM(); }
#endif
    if (IN(4)) { phaseY(a, gw, NGW, lane); if (BOTH(4)) SEAM(); }
#if OPT_GEMM
    if (IN(5)) { phase4_gemm(a, lds, tid, wave, lane); if (BOTH(5)) SEAM(); }
#else
    if (IN(5)) { phase4_simple(a, gt, NGT); if (BOTH(5)) SEAM(); }
#endif
    if (IN(6)) { phase5(a, gw, NGW, lane); }
}

extern "C" void kernel_launch(void* const* d_in, const int* in_sizes, int n_in, void* d_out, int out_size, void* d_ws, size_t ws_size, hipStream_t stream) {
    static int grid = 0;
    if (grid == 0) {
        if (n_in != 18 || in_sizes[0] != T * DM || out_size != T * DM || ws_size < WS_END) { fprintf(stderr, "kernel_launch: unexpected shapes (n_in %d, ws %zu)\n", n_in, ws_size); grid = -1; return; }
        int dev = 0, cus = 0, per_cu = 0;
        (void)hipGetDevice(&dev);
        (void)hipDeviceGetAttribute(&cus, hipDeviceAttributeMultiprocessorCount, dev);
        (void)hipFuncSetAttribute((const void*)mega, hipFuncAttributeMaxDynamicSharedMemorySize, LDS_BYTES);
        if (hipOccupancyMaxActiveBlocksPerMultiprocessor(&per_cu, (const void*)mega, 256, LDS_BYTES) != hipSuccess || per_cu < 1) { fprintf(stderr, "kernel_launch: occupancy query failed (%d)\n", per_cu); per_cu = 1; }
        (void)hipGetLastError();
        if (per_cu > 2) per_cu = 2;
        grid = cus * per_cu;
        fprintf(stderr, "kernel_launch: %d CUs x %d blocks\n", cus, per_cu);
    }
    if (grid < 0) return;
    Args a{};
    for (int i = 0; i < 18; ++i) a.in[i] = (const float*)d_in[i];
    a.out = (float*)d_out; a.ws = (unsigned char*)d_ws;
#if MK_LAUNCHES == 1
    (void)hipMemsetAsync((char*)d_ws + WS_BAR, 0, 16384, stream);
    a.ph_lo = 0; a.ph_hi = NPHASE;
    void* args[] = {&a};
    hipError_t e = hipLaunchCooperativeKernel((const void*)mega, dim3(grid), dim3(256), args, LDS_BYTES, stream);
    if (e != hipSuccess) fprintf(stderr, "cooperative launch failed: %s (grid %d)\n", hipGetErrorString(e), grid);
#else
    for (int p = 0; p < NPHASE; ++p) {
        a.ph_lo = p; a.ph_hi = p + 1;
        hipLaunchKernelGGL(mega, dim3(grid), dim3(256), LDS_BYTES, stream, a);
    }
#endif
}
```
